# Optimizing an MI355X kernel written in HIP

```python
import math
import jax
import jax.numpy as jnp
from jax import lax
import numpy as np

D_MODEL = 1024
BATCH = 32
SEQ = 256
DEPTH = 2
DEC_BATCH = 8
DEC_SEQ = 2048
PAST_LEN = 256

GRID_W = 64
ROPE_THETA = 10000.0
EPS = 1e-6
Q_BLOCK = 128
MLA_HEADS = 4
MLA_NOPE = 64
MLA_ROPE = 32
MLA_V = 64
MLA_Q_RANK = 256
MLA_KV_RANK = 128
ML_HEADS = 4
ML_DH = 128
ML_WIDTH = ML_HEADS * ML_DH
ML_CHUNK = 128
GQA_HEADS = 4
GQA_KV_HEADS = 2
GQA_DH = 64
D_FF = 2816

A_WIDTH = MLA_HEADS * MLA_V
C_WIDTH = GQA_HEADS * GQA_DH
MIX_WIDTH = A_WIDTH + ML_WIDTH + C_WIDTH
IN_SIZES = (MLA_Q_RANK, MLA_KV_RANK, MLA_ROPE, ML_WIDTH, ML_WIDTH, ML_WIDTH, 4 * ML_HEADS,
            GQA_HEADS * GQA_DH, GQA_KV_HEADS * GQA_DH, GQA_KV_HEADS * GQA_DH)
IN_COLS = MLA_Q_RANK + MLA_KV_RANK + MLA_ROPE + 3 * ML_WIDTH + 4 * ML_HEADS + (GQA_HEADS + 2 * GQA_KV_HEADS) * GQA_DH
MLA_SCALE = (MLA_NOPE + MLA_ROPE) ** -0.5
GQA_SCALE = GQA_DH ** -0.5

kernel_name = 'hybrid_mla_mlstm_gqa_diffusion_step'


def rmsnorm(x, g):
    xf = x.astype(jnp.float32)
    xf = xf * lax.rsqrt(jnp.mean(xf * xf, axis=-1, keepdims=True) + EPS)
    return xf.astype(x.dtype) * g


def grid_positions(n_tokens):
    rows = n_tokens // GRID_W
    r, c = jnp.meshgrid(jnp.arange(rows, dtype=jnp.int32), jnp.arange(GRID_W, dtype=jnp.int32), indexing='ij')
    return r.reshape(-1), c.reshape(-1)


def rope_1d(x, pos):
    d = x.shape[-1]
    inv = ROPE_THETA ** (-jnp.arange(0, d, 2, dtype=jnp.float32) / d)
    ang = pos.astype(jnp.float32)[:, None] * inv[None, :]
    cos = jnp.cos(ang)[:, None, :].astype(x.dtype)
    sin = jnp.sin(ang)[:, None, :].astype(x.dtype)
    x1, x2 = x[..., : d // 2], x[..., d // 2:]
    return jnp.concatenate([x1 * cos - x2 * sin, x1 * sin + x2 * cos], axis=-1)


def rope_2d(x, rows, cols):
    h = x.shape[-1] // 2
    return jnp.concatenate([rope_1d(x[..., :h], rows), rope_1d(x[..., h:], cols)], axis=-1)


def dwconv_centred(x, w, b):
    k = w.shape[0]
    p = k // 2
    t = x.shape[1]
    xp = jnp.pad(x, ((0, 0), (p, p), (0, 0)))
    return sum(xp[:, j:j + t] * w[j] for j in range(k)) + b


def modulation(cvec, lp):
    m = jax.nn.silu(cvec) @ lp['w_ada'] + lp['b_ada']
    return jnp.split(m[:, None, :], 6, axis=-1)


def adaln_in(x, g, shift, scale):
    return rmsnorm(x, g) * (1.0 + scale) + shift


def split_in(z):
    idx = [int(v) for v in np.cumsum(IN_SIZES)[:-1]]
    return jnp.split(z, idx, axis=-1)


def block_attention(q, k, v, scale):
    b, tq, h, dk = q.shape
    hk = k.shape[2]
    g = h // hk
    nb = tq // Q_BLOCK
    qb = q.reshape(b, nb, Q_BLOCK, hk, g, dk).transpose(1, 0, 2, 3, 4, 5)

    def one(qblk):
        s = jnp.einsum('bqhgd,bkhd->bhgqk', qblk, k).astype(jnp.float32) * scale
        p = jax.nn.softmax(s, axis=-1).astype(v.dtype)
        return jnp.einsum('bhgqk,bkhd->bqhgd', p, v)

    o = lax.map(one, qb)
    return o.transpose(1, 0, 2, 3, 4, 5).reshape(b, tq, h, v.shape[-1])


def mla_queries(cq, lp):
    b, t, _ = cq.shape
    q = (rmsnorm(cq, lp['g_mla_q']) @ lp['w_mla_uq']).reshape(b, t, MLA_HEADS, MLA_NOPE + MLA_ROPE)
    return q[..., :MLA_NOPE], q[..., MLA_NOPE:]


def mla_kv(ckv, lp):
    b, t, _ = ckv.shape
    kv = (ckv @ lp['w_mla_ukv']).reshape(b, t, MLA_HEADS, MLA_NOPE + MLA_V)
    return kv[..., :MLA_NOPE], kv[..., MLA_NOPE:]


def mla_keys(k_nope, k_rope):
    kr = jnp.broadcast_to(k_rope[:, :, None, :], k_nope.shape[:-1] + (MLA_ROPE,))
    return jnp.concatenate([k_nope, kr], axis=-1)


def gqa_qkv(q_g, k_g, v_g, lp):
    b, t, _ = q_g.shape
    q = rmsnorm(q_g.reshape(b, t, GQA_HEADS, GQA_DH), lp['g_gqa_q'])
    k = rmsnorm(k_g.reshape(b, t, GQA_KV_HEADS, GQA_DH), lp['g_gqa_k'])
    v = v_g.reshape(b, t, GQA_KV_HEADS, GQA_DH)
    return q, k, v


def mlstm_chunkwise(q, k, v, i_pre, f_pre, c0, n0, m0):
    b, t, h, d = q.shape
    lc = ML_CHUNK
    nc = t // lc

    def to_chunks(a):
        a = a.astype(jnp.float32).reshape((b, nc, lc, h) + a.shape[3:])
        return jnp.swapaxes(jnp.moveaxis(a, 1, 0), 2, 3)

    li_all = i_pre
    lf_all = jax.nn.log_sigmoid(f_pre.astype(jnp.float32))
    xs = (to_chunks(q), to_chunks(k), to_chunks(v), to_chunks(li_all), to_chunks(lf_all))
    tri = jnp.tril(jnp.ones((lc, lc), dtype=bool))

    def step(carry, xc):
        cm, nm, mm = carry
        qc, kc, vc, li, lf = xc
        bc = jnp.cumsum(lf, axis=-1)
        dlog = bc[..., :, None] - bc[..., None, :] + li[..., None, :]
        dlog = jnp.where(tri, dlog, -jnp.inf)
        g = bc + mm[..., None]
        m_t = jnp.maximum(g, jnp.max(dlog, axis=-1))
        w = jnp.exp(dlog - m_t[..., None])
        inter = jnp.exp(g - m_t)
        s = jnp.einsum('bhtd,bhsd->bhts', qc, kc) * w
        num = jnp.einsum('bhts,bhsd->bhtd', s, vc) + inter[..., None] * jnp.einsum('bhtd,bhde->bhte', qc, cm)
        den = jnp.sum(s, axis=-1) + inter * jnp.einsum('bhtd,bhd->bht', qc, nm)
        hc = num / jnp.maximum(jnp.abs(den), jnp.exp(-m_t))[..., None]
        b_last = bc[..., -1]
        m_new = m_t[..., -1]
        wk = jnp.exp(b_last[..., None] - bc + li - m_new[..., None])
        decay = jnp.exp(b_last + mm - m_new)
        c_new = decay[..., None, None] * cm + jnp.einsum('bhs,bhsd,bhse->bhde', wk, kc, vc)
        n_new = decay[..., None] * nm + jnp.einsum('bhs,bhsd->bhd', wk, kc)
        return (c_new, n_new, m_new), hc

    init = (c0.astype(jnp.float32), n0.astype(jnp.float32), m0.astype(jnp.float32))
    (cf, nf, mf), hs = lax.scan(step, init, xs)
    hs = hs.transpose(1, 0, 3, 2, 4).reshape(b, t, h, d)
    return hs, (cf, nf, mf)


def mlstm_mixer(u, v_ml, o_ml, gates, lp, c0, n0, m0):
    b, t, _ = u.shape
    uc = jax.nn.silu(dwconv_centred(u, lp['w_ml_conv'], lp['b_ml_conv'])).reshape(b, t, ML_HEADS, ML_DH)
    q = jnp.einsum('bthd,hde->bthe', uc, lp['w_ml_q'])
    k = jnp.einsum('bthd,hde->bthe', uc, lp['w_ml_k']) * (ML_DH ** -0.5)
    v = v_ml.reshape(b, t, ML_HEADS, ML_DH)
    g = (gates + lp['b_ml_gates']).astype(jnp.float32).reshape(b, t, 4, ML_HEADS)
    h_f, (cf, nf, mf) = mlstm_chunkwise(q, k, v, g[:, :, 0], g[:, :, 1], c0[:, 0], n0[:, 0], m0[:, 0])
    rev = lambda a: jnp.flip(a, axis=1)
    h_b, (cb, nb, mb) = mlstm_chunkwise(rev(q), rev(k), rev(v), rev(g[:, :, 2]), rev(g[:, :, 3]),
                                        c0[:, 1], n0[:, 1], m0[:, 1])
    hsum = (h_f + rev(h_b)).astype(u.dtype)
    hn = rmsnorm(hsum, lp['g_ml_out'].reshape(ML_HEADS, ML_DH)).reshape(b, t, ML_WIDTH)
    out = hn * jax.nn.sigmoid(o_ml)
    return out, (jnp.stack([cf, cb], axis=1), jnp.stack([nf, nb], axis=1), jnp.stack([mf, mb], axis=1))


def merge_heads(o_a, o_b, o_c, lp):
    b, t = o_b.shape[:2]
    o = jnp.concatenate([o_a.reshape(b, t, A_WIDTH), o_b, o_c.reshape(b, t, C_WIDTH)], axis=-1)
    return o @ lp['w_out']


def mixer_context(y, lp):
    b, t, _ = y.shape
    cq, ckv_raw, krope, u, v_ml, o_ml, gates, q_g, k_g, v_g = split_in(y @ lp['w_in'])
    ckv = rmsnorm(ckv_raw, lp['g_mla_kv'])
    q_nope, q_rope = mla_queries(cq, lp)
    k_nope, v_a = mla_kv(ckv, lp)
    o_a = block_attention(jnp.concatenate([q_nope, q_rope], axis=-1), mla_keys(k_nope, krope), v_a, MLA_SCALE)
    c0 = jnp.zeros((b, 2, ML_HEADS, ML_DH, ML_DH), y.dtype)
    n0 = jnp.zeros((b, 2, ML_HEADS, ML_DH), y.dtype)
    m0 = jnp.zeros((b, 2, ML_HEADS), y.dtype)
    o_b, (cs, ns, ms) = mlstm_mixer(u, v_ml, o_ml, gates, lp, c0, n0, m0)
    q_c, k_c, v_c = gqa_qkv(q_g, k_g, v_g, lp)
    o_c = block_attention(q_c, k_c, v_c, GQA_SCALE)
    return merge_heads(o_a, o_b, o_c, lp), (ckv, krope, k_c, v_c, cs, ns, ms)


def mixer_latent(y, lp, ctx, rows, cols):
    ckv_ctx, krope_ctx, k_ctx, v_ctx, c0, n0, m0 = ctx
    cq, ckv_raw, krope, u, v_ml, o_ml, gates, q_g, k_g, v_g = split_in(y @ lp['w_in'])
    q_nope, q_rope = mla_queries(cq, lp)
    q_a = jnp.concatenate([q_nope, rope_2d(q_rope, rows, cols)], axis=-1)
    k_nope, v_lat = mla_kv(rmsnorm(ckv_raw, lp['g_mla_kv']), lp)
    kr = rope_2d(krope[:, :, None, :], rows, cols)[:, :, 0]
    k_nope_c, v_ctx_a = mla_kv(ckv_ctx, lp)
    k_a = jnp.concatenate([mla_keys(k_nope, kr), mla_keys(k_nope_c, krope_ctx)], axis=1)
    v_a = jnp.concatenate([v_lat, v_ctx_a], axis=1)
    o_a = block_attention(q_a, k_a, v_a, MLA_SCALE)
    o_b, _ = mlstm_mixer(u, v_ml, o_ml, gates, lp, c0, n0, m0)
    q_c, k_c, v_c = gqa_qkv(q_g, k_g, v_g, lp)
    q_c = rope_2d(q_c, rows, cols)
    k_c = rope_2d(k_c, rows, cols)
    o_c = block_attention(q_c, jnp.concatenate([k_c, k_ctx], axis=1), jnp.concatenate([v_c, v_ctx], axis=1), GQA_SCALE)
    return merge_heads(o_a, o_b, o_c, lp)


def conv_ffn(y, lp):
    a, g = jnp.split(y @ lp['w_ff_up'], 2, axis=-1)
    g = dwconv_centred(g, lp['w_ff_conv'], lp['b_ff_conv'])
    return (jax.nn.silu(g) * a) @ lp['w_ff_down']


def setup_inputs(seed: int = 0) -> dict:
    key = jax.random.key(seed)
    ks = iter(jax.random.split(key, 40))

    def nrm(shape, scale=1.0):
        return jax.random.normal(next(ks), shape, jnp.float32) * scale

    L = DEPTH
    gate_base = jnp.repeat(jnp.array([0.0, 3.0, 0.0, 3.0], jnp.float32), ML_HEADS)
    return {
        'x_prompt': nrm((BATCH, SEQ, D_MODEL)),
        'x_sample': nrm((DEC_BATCH, DEC_SEQ, D_MODEL)),
        'cache_mla_ckv': nrm((DEC_BATCH, L, PAST_LEN, MLA_KV_RANK)),
        'cache_mla_krope': nrm((DEC_BATCH, L, PAST_LEN, MLA_ROPE)),
        'cache_gqa_k': nrm((DEC_BATCH, L, PAST_LEN, GQA_KV_HEADS, GQA_DH)),
        'cache_gqa_v': nrm((DEC_BATCH, L, PAST_LEN, GQA_KV_HEADS, GQA_DH)),
        'state_mlstm_C': nrm((DEC_BATCH, L, 2, ML_HEADS, ML_DH, ML_DH), 0.1),
        'state_mlstm_n': nrm((DEC_BATCH, L, 2, ML_HEADS, ML_DH), 0.1),
        'state_mlstm_m': nrm((DEC_BATCH, L, 2, ML_HEADS)),
        'c': nrm((DEC_BATCH, D_MODEL)),
        'c_ctx': nrm((D_MODEL,)),
        'w_ada': nrm((L, D_MODEL, 6 * D_MODEL), 0.5 * D_MODEL ** -0.5),
        'b_ada': nrm((L, 6 * D_MODEL), 0.01),
        'g_norm1': 1.0 + nrm((L, D_MODEL), 0.01),
        'g_norm2': 1.0 + nrm((L, D_MODEL), 0.01),
        'w_in': nrm((L, D_MODEL, IN_COLS), D_MODEL ** -0.5),
        'g_mla_q': 1.0 + nrm((L, MLA_Q_RANK), 0.01),
        'w_mla_uq': nrm((L, MLA_Q_RANK, MLA_HEADS * (MLA_NOPE + MLA_ROPE)), MLA_Q_RANK ** -0.5),
        'g_mla_kv': 1.0 + nrm((L, MLA_KV_RANK), 0.01),
        'w_mla_ukv': nrm((L, MLA_KV_RANK, MLA_HEADS * (MLA_NOPE + MLA_V)), MLA_KV_RANK ** -0.5),
        'w_ml_conv': nrm((L, 3, ML_WIDTH), 0.5),
        'b_ml_conv': nrm((L, ML_WIDTH), 0.01),
        'w_ml_q': nrm((L, ML_HEADS, ML_DH, ML_DH), ML_DH ** -0.5),
        'w_ml_k': nrm((L, ML_HEADS, ML_DH, ML_DH), ML_DH ** -0.5),
        'b_ml_gates': gate_base + nrm((L, 4 * ML_HEADS), 0.1),
        'g_ml_out': 1.0 + nrm((L, ML_WIDTH), 0.01),
        'g_gqa_q': 1.0 + nrm((L, GQA_DH), 0.01),
        'g_gqa_k': 1.0 + nrm((L, GQA_DH), 0.01),
        'w_out': nrm((L, MIX_WIDTH, D_MODEL), MIX_WIDTH ** -0.5),
        'w_ff_up': nrm((L, D_MODEL, 2 * D_FF), D_MODEL ** -0.5),
        'w_ff_conv': nrm((L, 3, D_FF), 0.5),
        'b_ff_conv': nrm((L, D_FF), 0.01),
        'w_ff_down': nrm((L, D_FF, D_MODEL), D_FF ** -0.5),
        'g_final': 1.0 + nrm((D_MODEL,), 0.01),
    }


def reference(x_prompt, x_sample, cache_mla_ckv, cache_mla_krope, cache_gqa_k, cache_gqa_v,
              state_mlstm_C, state_mlstm_n, state_mlstm_m, c, c_ctx,
              w_ada, b_ada, g_norm1, g_norm2, w_in, g_mla_q, w_mla_uq, g_mla_kv, w_mla_ukv,
              w_ml_conv, b_ml_conv, w_ml_q, w_ml_k, b_ml_gates, g_ml_out, g_gqa_q, g_gqa_k,
              w_out, w_ff_up, w_ff_conv, b_ff_conv, w_ff_down, g_final):
    params = {
        'w_ada': w_ada, 'b_ada': b_ada, 'g_norm1': g_norm1, 'g_norm2': g_norm2, 'w_in': w_in,
        'g_mla_q': g_mla_q, 'w_mla_uq': w_mla_uq, 'g_mla_kv': g_mla_kv, 'w_mla_ukv': w_mla_ukv,
        'w_ml_conv': w_ml_conv, 'b_ml_conv': b_ml_conv, 'w_ml_q': w_ml_q, 'w_ml_k': w_ml_k,
        'b_ml_gates': b_ml_gates, 'g_ml_out': g_ml_out, 'g_gqa_q': g_gqa_q, 'g_gqa_k': g_gqa_k,
        'w_out': w_out, 'w_ff_up': w_ff_up, 'w_ff_conv': w_ff_conv, 'b_ff_conv': b_ff_conv,
        'w_ff_down': w_ff_down,
    }
    rows, cols = grid_positions(x_sample.shape[1])
    xp = x_prompt
    xs = x_sample
    new_state = [[] for _ in range(7)]
    for l in range(DEPTH):
        lp = {name: arr[l] for name, arr in params.items()}
        sh1, sc1, gt1, sh2, sc2, gt2 = modulation(c_ctx[None, :], lp)
        out, ctx_t = mixer_context(adaln_in(xp, lp['g_norm1'], sh1, sc1), lp)
        xp = xp + gt1 * out
        xp = xp + gt2 * conv_ffn(adaln_in(xp, lp['g_norm2'], sh2, sc2), lp)
        for acc, tns in zip(new_state, ctx_t):
            acc.append(tns)
        cache_l = (cache_mla_ckv[:, l], cache_mla_krope[:, l], cache_gqa_k[:, l], cache_gqa_v[:, l],
                   state_mlstm_C[:, l], state_mlstm_n[:, l], state_mlstm_m[:, l])
        sh1, sc1, gt1, sh2, sc2, gt2 = modulation(c, lp)
        xs = xs + gt1 * mixer_latent(adaln_in(xs, lp['g_norm1'], sh1, sc1), lp, cache_l, rows, cols)
        xs = xs + gt2 * conv_ffn(adaln_in(xs, lp['g_norm2'], sh2, sc2), lp)
    y_prompt = rmsnorm(xp, g_final)
    y_sample = rmsnorm(xs, g_final)
    new_mla_ckv = jnp.stack(new_state[0], axis=1)
    new_mla_krope = jnp.stack(new_state[1], axis=1)
    new_gqa_k = jnp.stack(new_state[2], axis=1)
    new_gqa_v = jnp.stack(new_state[3], axis=1)
    new_mlstm_C = jnp.stack(new_state[4], axis=1)
    new_mlstm_n = jnp.stack(new_state[5], axis=1)
    new_mlstm_m = jnp.stack(new_state[6], axis=1)
    return (y_prompt, y_sample, new_mla_ckv, new_mla_krope, new_gqa_k, new_gqa_v, new_mlstm_C, new_mlstm_n, new_mlstm_m)
```

```cpp
#include <hip/hip_runtime.h>
#include <hip/hip_cooperative_groups.h>
#include <cstdio>
namespace cg = cooperative_groups;

#ifndef PROBE
#define PROBE 0
#endif
#ifndef STAGGER
#define STAGGER 0
#endif
#define DI __device__ __forceinline__
#define LAS __attribute__((address_space(3)))
typedef unsigned short bf16_t;
typedef short bf16x8 __attribute__((ext_vector_type(8)));
typedef float f32x4 __attribute__((ext_vector_type(4)));
typedef unsigned u32x4 __attribute__((ext_vector_type(4)));
typedef unsigned u32x2 __attribute__((ext_vector_type(2)));

constexpr int NT = 24576, NCTX = 8192, NA2 = 26624;
constexpr float EPS = 1e-6f;
constexpr float LOG2E = 1.4426950408889634f;
constexpr int ZC_U = 416, ZC_VML = 928, ZC_GATES = 1952, ZC_QG = 1968, ZC_END = 2480;
enum { I_XP = 0, I_XS, I_CCKV, I_CKROPE, I_CGK, I_CGV, I_SC, I_SN, I_SM, I_C, I_CCTX, I_WADA, I_BADA, I_GN1, I_GN2, I_WIN, I_GMQ, I_WUQ, I_GMKV, I_WUKV,
       I_WMLC, I_BMLC, I_WMLQ, I_WMLK, I_BGATES, I_GMLOUT, I_GGQ, I_GGK, I_WOUT, I_WUP, I_WFC, I_BFC, I_WDN, I_GFIN, N_IN };
constexpr size_t O_X = 0, O_CKV = 25165824, O_KROPE = 27262976, O_GK = 27787264, O_GV = 29884416, O_C = 31981568, O_N = 40370176, O_M = 40435712;
constexpr size_t WS_CTRL = 0, WS_BAR = 4096, WS_ROPE = 20480, WS_MOD = 32768, WS_W = WS_MOD + 442368;
constexpr size_t W_IN = 0, W_B2 = W_IN + 5242880, W_B3 = W_B2 + 786432, W_OUT = W_B3 + 1048576, W_UP = W_OUT + 2097152, W_DN = W_UP + 11534336, W_SZ = W_UP + 25165824;
constexpr size_t WS_RA = WS_W + W_SZ, RSZ = 50331648;
constexpr size_t WS_RB = WS_RA + RSZ, WS_RC = WS_RB + RSZ, WS_RE = WS_RC + RSZ, WS_RF = WS_RE + 25165824;
constexpr size_t F_GATES = 0, F_CKG = F_GATES + 1572864, F_CVG = F_CKG + 524288, F_KROPE = F_CVG + 524288, F_QMLA = F_KROPE + 1703936, F_KVMLA = F_QMLA + 18874368, F_SZ = F_KVMLA + 27262976;
constexpr size_t WS_END = WS_RF + F_SZ;
static_assert(WS_END <= 268435456ull, "workspace over 256 MiB");
static_assert(WS_RB + (size_t)NT * 2816 * 2 + (size_t)384 * 6 * 2816 * 4 <= WS_END, "FFN buffers overflow");
constexpr int LDS_BYTES = 147456;

struct Params { const float* in[N_IN]; float* out; unsigned char* ws; };
struct PA { const __attribute__((address_space(4))) Params* pp;
    __device__ __forceinline__ const float* in(int i) const { return pp->in[i]; }
    __device__ __forceinline__ float* out() const { return pp->out; }
    __device__ __forceinline__ unsigned char* ws() const { return pp->ws; } };

DI int tidx() { int t = __builtin_amdgcn_workitem_id_x(); asm volatile("" : "+v"(t)); return t; }
DI int bidx() { int b = __builtin_amdgcn_workgroup_id_x(); asm volatile("" : "+s"(b)); return b; }
DI int gdim() { int g = (int)__ockl_get_num_groups(0); asm volatile("" : "+s"(g)); return g; }
typedef float f32x2 __attribute__((ext_vector_type(2)));
typedef __bf16 bf16x2v __attribute__((ext_vector_type(2)));
DI unsigned cvt_pk_bf16(float lo, float hi) { const f32x2 v = {lo, hi}; return __builtin_bit_cast(unsigned, __builtin_convertvector(v, bf16x2v)); }
DI float bf2f(bf16_t b) { return __uint_as_float(((unsigned)b) << 16); }
DI float bflo(unsigned u) { return __uint_as_float(u << 16); }
DI float bfhi(unsigned u) { return __uint_as_float(u & 0xffff0000u); }
DI bf16_t f2bf(float f) { return (bf16_t)(cvt_pk_bf16(f, 0.f) & 0xffffu); }
DI float max3f(float a, float b, float c) { return fmaxf(fmaxf(a, b), c); }
DI float exp2raw(float x) { return __builtin_amdgcn_exp2f(x); }
DI float wave_sum(float v) { for (int o = 32; o >= 1; o >>= 1) v += __shfl_xor(v, o); return v; }
DI float sigmoidf(float x) { return __builtin_amdgcn_rcpf(1.f + __builtin_amdgcn_exp2f(-LOG2E * x)); }
DI float siluf(float x) { return x * sigmoidf(x); }
DI float row_prev(float v) { return __builtin_bit_cast(float, __builtin_amdgcn_update_dpp(0, __builtin_bit_cast(int, v), 0x121, 0xf, 0xf, false)); }
DI float row_next(float v) { return __builtin_bit_cast(float, __builtin_amdgcn_update_dpp(0, __builtin_bit_cast(int, v), 0x12f, 0xf, 0xf, false)); }
DI float row_shr1(float edge, float v) { return __builtin_bit_cast(float, __builtin_amdgcn_update_dpp(__builtin_bit_cast(int, edge), __builtin_bit_cast(int, v), 0x111, 0xf, 0xf, false)); }
DI float row_shl1(float edge, float v) { return __builtin_bit_cast(float, __builtin_amdgcn_update_dpp(__builtin_bit_cast(int, edge), __builtin_bit_cast(int, v), 0x101, 0xf, 0xf, false)); }
DI int mod_index(int row) { return row < NCTX ? 0 : 1 + ((row - NCTX) >> 11); }
DI void seq_pos(int t, int& pos, int& T) { if (t < NCTX) { pos = t & 255; T = 256; } else { pos = (t - NCTX) & 2047; T = 2048; } }


#define XB_TMO      128
#define XB_XCNT(j)  (256  + 64 * (j))
#define XB_XSUB(j)  (1280 + 64 * (j))
#define XB_XGEN(j)  (2304 + 64 * (j))
#define XB_TOP      3328
#define XB_TOPGEN   3392
#define XCD_BAR_WORDS 3456
#define XB_SPIN_CAP (1u << 18)
DI unsigned xb_ld(unsigned* p)              { return __hip_atomic_load(p, __ATOMIC_RELAXED, __HIP_MEMORY_SCOPE_AGENT); }
DI unsigned xb_add(unsigned* p, unsigned v) { return __hip_atomic_fetch_add(p, v, __ATOMIC_RELAXED, __HIP_MEMORY_SCOPE_AGENT); }
DI unsigned xb_xcc_id() { return (unsigned)__builtin_amdgcn_s_getreg((3 << 11) | 20) & 0xFu; }
#define XB_SPIN(cond, bar) do { unsigned _sp = 0; while (cond) { __builtin_amdgcn_s_sleep(1); \
    if ((++_sp & 255u) == 0u) { if (xb_ld(&(bar)[XB_TMO])) break; if (_sp > XB_SPIN_CAP) { atomicAdd(&(bar)[XB_TMO], 1u); break; } } } } while (0)
struct XcdBarrier { unsigned* bar; unsigned x; volatile LAS unsigned* st; };
DI XcdBarrier xcd_barrier_post(unsigned* bar, volatile LAS unsigned* st) {
    XcdBarrier b; b.bar = bar; b.x = xb_xcc_id(); b.st = st;
    if (tidx() == 0) (void)xb_add(&bar[XB_XCNT(b.x)], 1u);
    return b;
}
DI void xcd_barrier_complete(unsigned* bar, unsigned x, unsigned& nloc, unsigned& nx) {
    const unsigned G = (unsigned)gdim();
    unsigned sum, cnt, mine, sp = 0u;
    for (;;) {
        sum = 0u; cnt = 0u; mine = 0u;
#pragma unroll
        for (unsigned j = 0; j < 16; ++j) { const unsigned c = xb_ld(&bar[XB_XCNT(j)]); sum += c; cnt += (c > 0u) ? 1u : 0u; mine = (j == x) ? c : mine; }
        if (sum == G) break;
        __builtin_amdgcn_s_sleep(1);
        if ((++sp & 255u) == 0u) { if (xb_ld(&bar[XB_TMO])) break; if (sp > XB_SPIN_CAP) { atomicAdd(&bar[XB_TMO], 1u); break; } }
    }
    nloc = mine > 0u ? mine : 1u; nx = cnt > 0u ? cnt : 1u;
}
DI void xcd_barrier(const XcdBarrier& b) {
    asm volatile("s_waitcnt vmcnt(0)" ::: "memory");
    __syncthreads();
    if (tidx() == 0) {
        unsigned* bar = b.bar;
        __builtin_amdgcn_s_waitcnt(0);
        unsigned nloc = b.st[0], nx = b.st[1];
        if (nloc == 0u) { xcd_barrier_complete(bar, b.x, nloc, nx); b.st[0] = nloc; b.st[1] = nx; }
        const unsigned old = xb_add(&bar[XB_XSUB(b.x)], 1u);
        const unsigned gen = old / nloc;
        if (old + 1u == (gen + 1u) * nloc) {
            __builtin_amdgcn_fence(__ATOMIC_RELEASE, "agent");
            asm volatile("s_waitcnt vmcnt(0)" ::: "memory");
            const unsigned og = xb_add(&bar[XB_TOP], 1u);
            const unsigned tg = og / nx;
            if (og + 1u == (tg + 1u) * nx) xb_add(&bar[XB_TOPGEN], 1u);
            else XB_SPIN(xb_ld(&bar[XB_TOPGEN]) == tg, bar);
            __builtin_amdgcn_fence(__ATOMIC_ACQUIRE, "agent");
            xb_add(&bar[XB_XGEN(b.x)], 1u);
            asm volatile("s_waitcnt vmcnt(0)" ::: "memory");
        } else {
            XB_SPIN(xb_ld(&bar[XB_XGEN(b.x)]) == gen, bar);
            __builtin_amdgcn_fence(__ATOMIC_ACQUIRE, "agent");
            asm volatile("s_waitcnt vmcnt(0)" ::: "memory");
        }
    }
    __syncthreads();
}

namespace pg8 {
constexpr int BM = 256, BK = 64, HALF = 128, HTB = HALF * BK * 2, STAGE_BYTES = 8 * HTB, NXCD = 8, WGM = 4;
DI int lds_byte(int r, int c) { const int st = (r >> 4) * 2 + (c >> 5), rr = r & 15, cc = c & 31, ob = rr * 64 + cc * 2; return st * 1024 + (ob ^ (((ob >> 9) & 1) << 5)); }
DI void stage_rc(int b, int& R, int& C) { const int st = b / 1024, sb = b % 1024, swz = sb ^ (((sb >> 9) & 1) << 5); R = (st >> 1) * 16 + swz / 64; C = (st & 1) * 32 + (swz % 64) / 2; }
struct Unit { int pm, pn; };
struct Gemm { const bf16_t* A; const bf16_t* Bt; int M, N, K; };
struct StaticOrder {
    int nM, nN, nwg, G, c;
    DI void init(int M, int N, int G_, int c_) { nM = M / BM; nN = N / BM; nwg = nM * nN; G = G_; c = c_; }
    DI bool next(int i, Unit& u) const {
        const long L = (long)i * G + c; if (L >= nwg) return false;
        int wgid = (int)L; { const int q = nwg / NXCD, r = nwg % NXCD, xcd = wgid % NXCD, off = wgid / NXCD; wgid = (xcd < r ? xcd * (q + 1) : r * (q + 1) + (xcd - r) * q) + off; }
        const int nig = WGM * nN, gid = wgid / nig, fm = gid * WGM, gsz = (nM - fm) < WGM ? (nM - fm) : WGM;
        u.pm = fm + ((wgid % nig) % gsz); u.pn = (wgid % nig) / gsz; return true;
    }
};
template <class Epi>
DI void gemm_phase(LAS unsigned char* lds, const Gemm g, const StaticOrder& S, const Epi& E) {
    const int tid = tidx(), wid = __builtin_amdgcn_readfirstlane(tid >> 6), lane = tid & 63, wr = wid >> 2, wc = wid & 3, fr = lane & 15, fq = lane >> 4;
    const int K = g.K, nt = K / BK;
    unsigned voffA[2];
#pragma unroll
    for (int i = 0; i < 2; ++i) { int R, C; stage_rc(tid * 16 + i * 8192, R, C); voffA[i] = (unsigned)(R * K + C) * 2u; }
    const size_t kstep = (size_t)(BK * 2);
    const size_t hstep = (size_t)HALF * K * 2;
    const size_t tstep = 2 * hstep;
    const unsigned ldsw = (unsigned)wid * 1024u;
    const int aoff = lds_byte(wr * 64 + fr, fq * 8), boff = lds_byte(wc * 32 + fr, fq * 8);
#define PG8_SA(b, h) (((b) * 2 + (h)) * HTB)
#define PG8_SB(b, h) ((4 + (b) * 2 + (h)) * HTB)
#define PG8_STAGE(bufoff, gbase, voff) do { _Pragma("unroll") for (int _i = 0; _i < 2; ++_i) \
        __builtin_amdgcn_global_load_lds((const unsigned*)((const char*)(gbase) + (voff)[_i]), (LAS unsigned*)(lds + (bufoff) + ldsw + _i * 8192), 16, 0, 0); } while (0)
#define PG8_LDA(dst, b, h) do { _Pragma("unroll") for (int m = 0; m < 4; ++m) _Pragma("unroll") for (int k = 0; k < 2; ++k) dst[m][k] = *(const LAS bf16x8*)(lds + PG8_SA(b, h) + aoff + m * 2048 + k * 1024); } while (0)
#define PG8_LDB(dst, b, h) do { _Pragma("unroll") for (int n = 0; n < 2; ++n) _Pragma("unroll") for (int k = 0; k < 2; ++k) dst[n][k] = *(const LAS bf16x8*)(lds + PG8_SB(b, h) + boff + n * 2048 + k * 1024); } while (0)
#define PG8_MMA(ai, bj, At, Bt) do { __builtin_amdgcn_s_setprio(1); _Pragma("unroll") for (int m = 0; m < 4; ++m) _Pragma("unroll") for (int n = 0; n < 2; ++n) _Pragma("unroll") for (int k = 0; k < 2; ++k) \
        acc[ai][bj][m][n] = __builtin_amdgcn_mfma_f32_16x16x32_bf16(Bt[n][k], At[m][k], acc[ai][bj][m][n], 0, 0, 0); __builtin_amdgcn_s_setprio(0); } while (0)
#define PG8_WAIT_V(n) asm volatile("s_waitcnt vmcnt(" #n ")" ::: "memory")
#define PG8_WAIT_L(n) asm volatile("s_waitcnt lgkmcnt(" #n ")" ::: "memory")
#define PG8_BAR __builtin_amdgcn_s_barrier()
#define PG8_SCHED __builtin_amdgcn_sched_barrier(0)
    Unit cur, nxt; int ui = 0;
    if (!S.next(0, cur)) return;
    f32x4 acc[2][2][4][2];
#pragma unroll
    for (int a = 0; a < 2; ++a)
#pragma unroll
        for (int b = 0; b < 2; ++b)
#pragma unroll
            for (int m = 0; m < 4; ++m)
#pragma unroll
                for (int n = 0; n < 2; ++n) acc[a][b][m][n] = (f32x4){0.f, 0.f, 0.f, 0.f};
    bf16x8 At[4][2], B0[2][2], B1[2][2];
    const char* cA = (const char*)g.A + (size_t)cur.pm * tstep; const char* cB = (const char*)g.Bt + (size_t)cur.pn * tstep;
    PG8_STAGE(PG8_SB(0, 0), cB, voffA); PG8_STAGE(PG8_SA(0, 0), cA, voffA); PG8_STAGE(PG8_SB(0, 1), cB + hstep, voffA); PG8_STAGE(PG8_SA(0, 1), cA + hstep, voffA);
    if (wr == 1) PG8_BAR;
    PG8_WAIT_V(4); PG8_BAR;
    PG8_STAGE(PG8_SB(1, 0), cB + kstep, voffA); PG8_STAGE(PG8_SA(1, 0), cA + kstep, voffA); PG8_STAGE(PG8_SB(1, 1), cB + hstep + kstep, voffA);
    PG8_WAIT_V(6); PG8_BAR;
    for (;;) {
        const bool has_next = S.next(ui + 1, nxt);
        const char* nA = has_next ? (const char*)g.A + (size_t)nxt.pm * tstep : cA; const char* nB = has_next ? (const char*)g.Bt + (size_t)nxt.pn * tstep : cB;
#pragma nounroll
        for (int t = 0; t < nt; t += 2) {
            const bool last = (t == nt - 2);
            const char* a1 = cA + (size_t)(t + 1) * kstep;
            const char* a2 = last ? nA : cA + (size_t)(t + 2) * kstep; const char* b2 = last ? nB : cB + (size_t)(t + 2) * kstep;
            const char* a3 = a2 + kstep; const char* b3 = b2 + kstep;
            PG8_LDB(B0, 0, 0); PG8_SCHED; PG8_LDA(At, 0, 0); PG8_STAGE(PG8_SA(1, 1), a1 + hstep, voffA);
            PG8_WAIT_L(8); PG8_BAR; PG8_WAIT_L(0); PG8_MMA(0, 0, At, B0); PG8_BAR; PG8_SCHED;
            PG8_LDB(B1, 0, 1); PG8_STAGE(PG8_SB(0, 0), b2, voffA);
            PG8_BAR; PG8_WAIT_L(0); PG8_MMA(0, 1, At, B1); PG8_BAR;
            PG8_LDA(At, 0, 1); PG8_STAGE(PG8_SA(0, 0), a2, voffA);
            PG8_BAR; PG8_WAIT_L(0); PG8_MMA(1, 0, At, B0); PG8_BAR; PG8_SCHED;
            PG8_STAGE(PG8_SB(0, 1), b2 + hstep, voffA);
            PG8_WAIT_V(6); PG8_BAR; PG8_MMA(1, 1, At, B1); PG8_BAR;
            PG8_LDB(B0, 1, 0); PG8_SCHED; PG8_LDA(At, 1, 0); PG8_STAGE(PG8_SA(0, 1), a2 + hstep, voffA);
            PG8_WAIT_L(8); PG8_BAR; PG8_WAIT_L(0); PG8_MMA(0, 0, At, B0); PG8_BAR; PG8_SCHED;
            PG8_LDB(B1, 1, 1); PG8_STAGE(PG8_SB(1, 0), b3, voffA);
            PG8_BAR; PG8_WAIT_L(0); PG8_MMA(0, 1, At, B1); PG8_BAR;
            PG8_LDA(At, 1, 1); PG8_STAGE(PG8_SA(1, 0), a3, voffA);
            PG8_BAR; PG8_WAIT_L(0); PG8_MMA(1, 0, At, B0); PG8_BAR; PG8_SCHED;
            PG8_STAGE(PG8_SB(1, 1), b3 + hstep, voffA);
            PG8_WAIT_V(6); PG8_BAR; PG8_MMA(1, 1, At, B1); PG8_BAR;
        }
        E(acc, cur, wr, wc, fr, fq);
#if PROBE == 12
        if (Epi::ID != 3) E(acc, cur, wr, wc, fr, fq);
#endif
        if (!has_next) break;
#pragma unroll
        for (int a = 0; a < 2; ++a)
#pragma unroll
            for (int b = 0; b < 2; ++b)
#pragma unroll
                for (int m = 0; m < 4; ++m)
#pragma unroll
                    for (int n = 0; n < 2; ++n) acc[a][b][m][n] = (f32x4){0.f, 0.f, 0.f, 0.f};
        cur = nxt; cA = nA; cB = nB; ++ui;
    }
    PG8_WAIT_V(0);
    if (wr == 0) PG8_BAR;
    PG8_BAR;
#undef PG8_SA
#undef PG8_SB
#undef PG8_STAGE
#undef PG8_LDA
#undef PG8_LDB
#undef PG8_MMA
#undef PG8_WAIT_V
#undef PG8_WAIT_L
#undef PG8_BAR
#undef PG8_SCHED
}
}
using pg8::Unit;

template <class F> DI void epi_foreach(const f32x4 (&acc)[2][2][4][2], const Unit& u, const F& f) {
    const int tl = tidx();
    const int fr = tl & 15, fq = (tl >> 4) & 3, wc = (tl >> 6) & 3, wr = tl >> 8;
    const int row0 = u.pm * 256 + wr * 64 + fr, col0 = u.pn * 256 + wc * 64 + 8 * fq;
#pragma unroll
    for (int ai = 0; ai < 2; ++ai)
#pragma unroll
        for (int m = 0; m < 4; ++m)
#pragma unroll
            for (int bj = 0; bj < 2; ++bj) f(row0 + ai * 128 + m * 16, col0 + bj * 32, acc[ai][bj][m][0], acc[ai][bj][m][1]);
}
DI void st_bf16x4(bf16_t* p, f32x4 v) { u32x2 w; w.x = cvt_pk_bf16(v[0], v[1]); w.y = cvt_pk_bf16(v[2], v[3]); *(u32x2*)p = w; }
DI void st_bf16x8(bf16_t* p, f32x4 v0, f32x4 v1) { u32x4 w; w.x = cvt_pk_bf16(v0[0], v0[1]); w.y = cvt_pk_bf16(v0[2], v0[3]); w.z = cvt_pk_bf16(v1[0], v1[1]); w.w = cvt_pk_bf16(v1[2], v1[3]); *(u32x4*)p = w; }

struct EpiIn { static constexpr int ID = 0;
    bf16_t* z1a; bf16_t* z2; bf16_t* z1b; float* gates; const float* bg;
    DI void operator()(const f32x4 (&acc)[2][2][4][2], const Unit& u, int, int, int, int) const {
        epi_foreach(acc, u, [&](int r, int c, f32x4 v0, f32x4 v1) {
            if (c < ZC_VML) st_bf16x8(z1a + (size_t)r * 928 + c, v0, v1);
            else if (c < ZC_GATES) st_bf16x8(z2 + (size_t)r * 1024 + (c - ZC_VML), v0, v1);
            else if (c < ZC_QG) { const f32x4 b0 = *(const f32x4*)(bg + (c - ZC_GATES)), b1 = *(const f32x4*)(bg + (c - ZC_GATES) + 4);
                                  *(f32x4*)(gates + (size_t)r * 16 + (c - ZC_GATES)) = v0 + b0; *(f32x4*)(gates + (size_t)r * 16 + (c - ZC_GATES) + 4) = v1 + b1; }
            else if (c < ZC_END) st_bf16x8(z1b + (size_t)r * 512 + (c - ZC_QG), v0, v1);
        });
    }
};
struct EpiA2 { static constexpr int ID = 1;
    bf16_t* qmla; bf16_t* kvmla; const f32x2* rope;
    DI void operator()(const f32x4 (&acc)[2][2][4][2], const Unit& u, int, int, int, int) const {
        epi_foreach(acc, u, [&](int r, int c, f32x4 v0, f32x4 v1) {
            if (c < 384) {
                if (r < NT) {
                    const int d = c % 96;
                    if (d >= 64 && r >= NCTX) {
                        const int pos = (r - NCTX) & 2047; const int half = (d - 64) >> 4, i0 = ((d - 64) & 15) >> 1;
                        const f32x2* t = rope + (half ? (pos & 63) : (pos >> 6)) * 8 + i0;
                        const f32x2 t0 = t[0], t1 = t[1], t2 = t[2], t3 = t[3];
                        v0 = (f32x4){v0[0] * t0.x - v0[1] * t0.y, v0[0] * t0.y + v0[1] * t0.x, v0[2] * t1.x - v0[3] * t1.y, v0[2] * t1.y + v0[3] * t1.x};
                        v1 = (f32x4){v1[0] * t2.x - v1[1] * t2.y, v1[0] * t2.y + v1[1] * t2.x, v1[2] * t3.x - v1[3] * t3.y, v1[2] * t3.y + v1[3] * t3.x};
                    }
                    st_bf16x8(qmla + (size_t)r * 384 + c, v0, v1);
                }
            } else if (c < 896) st_bf16x8(kvmla + (size_t)r * 512 + (c - 384), v0, v1);
        });
    }
};
struct EpiA3 { static constexpr int ID = 2;
    bf16_t* qk3;
    DI void operator()(const f32x4 (&acc)[2][2][4][2], const Unit& u, int, int, int, int) const {
        epi_foreach(acc, u, [&](int r, int c, f32x4 v0, f32x4 v1) {
            if (c >= 512) { v0 = v0 * 0.08838834764831845f; v1 = v1 * 0.08838834764831845f; }
            st_bf16x8(qk3 + (size_t)r * 1024 + c, v0, v1);
        });
    }
};
struct EpiRes { static constexpr int ID = 3;
    const float* src0; const float* src1; float* dst; const float* gate;
    DI void operator()(const f32x4 (&acc)[2][2][4][2], const Unit& u, int, int, int, int) const {
        const int tl = tidx(); const int fr = tl & 15, fq = (tl >> 4) & 3, wc = (tl >> 6) & 3, wr = tl >> 8;
        const int row0 = u.pm * 256 + wr * 64 + fr, col0 = u.pn * 256 + wc * 64 + 8 * fq;
        const float* gp = gate + (size_t)mod_index(u.pm * 256) * 6144 + col0;
        f32x4 g[2][2];
#pragma unroll
        for (int bj = 0; bj < 2; ++bj)
#pragma unroll
            for (int n = 0; n < 2; ++n) g[bj][n] = *(const f32x4*)(gp + bj * 32 + n * 4);
        const float* sbase = (u.pm * 256 < NCTX) ? src0 + (size_t)row0 * 1024 : src1 + (size_t)(row0 - NCTX) * 1024;
        float* dbase = dst + (size_t)row0 * 1024;
#pragma unroll
        for (int ai = 0; ai < 2; ++ai) {
            f32x4 x[4][2][2];
#pragma unroll
            for (int mm = 0; mm < 4; ++mm)
#pragma unroll
                for (int bj = 0; bj < 2; ++bj)
#pragma unroll
                    for (int n = 0; n < 2; ++n) x[mm][bj][n] = *(const f32x4*)(sbase + (size_t)(ai * 128 + mm * 16) * 1024 + col0 + bj * 32 + n * 4);
#pragma unroll
            for (int mm = 0; mm < 4; ++mm)
#pragma unroll
                for (int bj = 0; bj < 2; ++bj)
#pragma unroll
                    for (int n = 0; n < 2; ++n) *(f32x4*)(dbase + (size_t)(ai * 128 + mm * 16) * 1024 + col0 + bj * 32 + n * 4) = x[mm][bj][n] + g[bj][n] * acc[ai][bj][mm][n];
        }
    }
};
struct EpiUp { static constexpr int ID = 5;
    bf16_t* H; float* GB; float* AB; const float* wc; const float* bc;
    DI void operator()(const f32x4 (&acc)[2][2][4][2], const Unit& u, int, int, int, int) const {
        const int tl = tidx(); const int fr = tl & 15, fq = (tl >> 4) & 3, wcol = (tl >> 6) & 3, wr = tl >> 8;
        const int j = u.pn * 128 + wcol * 32 + 8 * fq;
        f32x4 w0[2], w1[2], w2[2], bb[2];
#pragma unroll
        for (int n = 0; n < 2; ++n) { w0[n] = *(const f32x4*)(wc + j + 4 * n); w1[n] = *(const f32x4*)(wc + 2816 + j + 4 * n); w2[n] = *(const f32x4*)(wc + 2 * 2816 + j + 4 * n); bb[n] = *(const f32x4*)(bc + j + 4 * n); }
#pragma unroll
        for (int ai = 0; ai < 2; ++ai)
#pragma unroll
            for (int m = 0; m < 4; ++m) {
                const int r = u.pm * 256 + ai * 128 + wr * 64 + m * 16 + fr;
                const int rr = (m * 16 + fr);
                f32x4 o[2];
#pragma unroll
                for (int n = 0; n < 2; ++n) {
                    const f32x4 a4 = acc[ai][0][m][n], g4 = acc[ai][1][m][n];
#pragma unroll
                    for (int i = 0; i < 4; ++i) {
                        float pm = 0.f, nm = 0.f;
                        if (m > 0) pm = row_prev(acc[ai][1][m > 0 ? m - 1 : 0][n][i]);
                        if (m < 3) nm = row_next(acc[ai][1][m < 3 ? m + 1 : 3][n][i]);
                        const float gp = row_shr1(pm, g4[i]), gn = row_shl1(nm, g4[i]);
                        o[n][i] = siluf(bb[n][i] + w0[n][i] * gp + w1[n][i] * g4[i] + w2[n][i] * gn) * a4[i];
                    }
                }
                if (rr != 0 && rr != 63) st_bf16x8(H + (size_t)r * 2816 + j, o[0], o[1]);
                if (rr <= 1 || rr >= 62) {
                    const int slot = rr <= 1 ? rr : rr - 60;
                    float* gb = GB + ((size_t)(r >> 6) * 4 + slot) * 2816 + j; *(f32x4*)gb = acc[ai][1][m][0]; *(f32x4*)(gb + 4) = acc[ai][1][m][1];
                    if (rr == 0 || rr == 63) { float* ab = AB + ((size_t)(r >> 6) * 2 + (rr == 63 ? 1 : 0)) * 2816 + j; *(f32x4*)ab = acc[ai][0][m][0]; *(f32x4*)(ab + 4) = acc[ai][0][m][1]; }
                }
            }
    }
};
template <class Epi> DI void run_gemm(unsigned char* smem, const bf16_t* A, const bf16_t* Bt, int M, int N, int K, const Epi& E) {
    pg8::Gemm g; g.A = A; g.Bt = Bt; g.M = M; g.N = N; g.K = K;
    pg8::StaticOrder S; S.init(M, N, (int)gdim(), (int)bidx());
    pg8::gemm_phase<Epi>((LAS unsigned char*)smem, g, S, E);
    __syncthreads();
}
DI int gemm_first_idle(int M, int N) { const int rem = ((M / 256) * (N / 256)) % gdim(); return rem == 0 ? gdim() : rem; }
DI int up_srccol(int n) { const int hb = n >> 8, r = n & 255; return r < 128 ? hb * 128 + r : 2816 + hb * 128 + (r - 128); }
DI int perm_row(int n) { const int rho = n & 31, nn = rho >> 4, i = rho & 15; return (n & ~31) + 8 * (i >> 2) + 4 * nn + (i & 3); }
DI int perm_row2(int n) { const int p = perm_row(n); const int s = p & 255, bj = s >> 7, wc = (s >> 5) & 3; return (p & ~255) + 64 * wc + 32 * bj + (s & 31); }
DI void convert_tiled(unsigned char* smem, const float* src, int ld, int K, int Nd, int nsrc, int kind, bf16_t* dst, int& item, const int nblk) {
    float* tile = (float*)smem;
    const int tk = K / 64, tn = Nd / 64, ntiles = tk * tn, tid = tidx();
    for (; item < ntiles; item += 2 * nblk) {
        float v[2][8];
#pragma unroll
        for (int tt = 0; tt < 2; ++tt) { const int it = item + tt * nblk; if (it < ntiles) {
            const int k0 = (it % tk) * 64, n0 = (it / tk) * 64;
            const int nn = tid & 63; const int n = kind >= 3 ? perm_row(n0 + nn + (kind == 4 ? 2816 : 0)) : perm_row2(n0 + nn); const int sc = kind >= 3 ? up_srccol(n) : (n < nsrc ? n : -1);
#pragma unroll
            for (int i = 0; i < 8; ++i) { const int kk = (tid >> 6) + 8 * i; v[tt][i] = sc >= 0 ? src[(size_t)(k0 + kk) * ld + sc] : 0.f; } } }
#pragma unroll
        for (int tt = 0; tt < 2; ++tt) { const int nn = tid & 63;
#pragma unroll
            for (int i = 0; i < 8; ++i) { const int kk = (tid >> 6) + 8 * i; tile[tt * 4160 + kk * 65 + nn] = v[tt][i]; } }
        __syncthreads();
#pragma unroll
        for (int tt = 0; tt < 2; ++tt) { const int it = item + tt * nblk; if (it < ntiles) {
            const int k0 = (it % tk) * 64, n0 = (it / tk) * 64;
#pragma unroll
            for (int i = 0; i < 8; ++i) { const int n2 = (tid >> 6) + 8 * i; const int k2 = tid & 63; dst[(size_t)(n0 + n2) * K + k0 + k2] = f2bf(tile[tt * 4160 + k2 * 65 + n2]); } } }
        __syncthreads();
    }
    item -= ntiles; if (item >= nblk) item -= nblk;
}
DI void convert_weights_b(unsigned char* smem, const PA& p, int l, int part, int bi, int nb) {
    unsigned char* W = p.ws() + WS_W;
    int item = bi;
    const float* wup = p.in(I_WUP) + (size_t)l * 1024 * 5632;
    if (part == 0) {
        convert_tiled(smem, wup, 5632, 1024, 2816, 5632, 3, (bf16_t*)(W + W_UP), item, nb);
        convert_tiled(smem, p.in(I_WDN) + (size_t)l * 2816 * 1024, 1024, 2816, 1024, 1024, 0, (bf16_t*)(W + W_DN), item, nb);
    } else {
        convert_tiled(smem, wup, 5632, 1024, 2816, 5632, 4, (bf16_t*)(W + W_UP) + (size_t)2816 * 1024, item, nb);
    }
}
DI void convert_weights(unsigned char* smem, const PA& p, int l, int bi, int nb) {
    unsigned char* W = p.ws() + WS_W;
    int item = bi;
    convert_tiled(smem, p.in(I_WIN) + (size_t)l * 1024 * 2480, 2480, 1024, 2560, 2480, 0, (bf16_t*)(W + W_IN), item, nb);
    convert_tiled(smem, p.in(I_WOUT) + (size_t)l * 1024 * 1024, 1024, 1024, 1024, 1024, 0, (bf16_t*)(W + W_OUT), item, nb);
    const float* wuq = p.in(I_WUQ) + (size_t)l * 256 * 384; const float* wukv = p.in(I_WUKV) + (size_t)l * 128 * 512;
    const float* wq = p.in(I_WMLQ) + (size_t)l * 4 * 128 * 128; const float* wk = p.in(I_WMLK) + (size_t)l * 4 * 128 * 128;
    bf16_t* b2 = (bf16_t*)(W + W_B2); bf16_t* b3 = (bf16_t*)(W + W_B3);
    const int gt = bi * 512 + tidx(), gs = nb * 512;
    for (int e = gt; e < 1024 * 384; e += gs) {
        const int n = perm_row2(e / 384), k = e % 384; float v = 0.f;
        if (n < 384) { if (k < 256) { const int hh = n / 96, r = n % 96; int sc = n;
                if (r >= 64) { const int q = r - 64, half = q >> 4, pp = q & 15; const int nat = (pp & 1) ? 8 + (pp >> 1) : (pp >> 1); sc = hh * 96 + 64 + half * 16 + nat; }
                v = wuq[(size_t)k * 384 + sc]; } }
        else if (n < 896) { if (k >= 256) v = wukv[(size_t)(k - 256) * 512 + (n - 384)]; }
        b2[e] = f2bf(v);
    }
    for (int e = gt; e < 1024 * 512; e += gs) {
        const int n = perm_row2(e / 512), k = e % 512; const int hh = (n & 511) >> 7, ee = n & 127; float v = 0.f;
        if ((k >> 7) == hh) v = (n < 512 ? wq : wk)[(size_t)hh * 16384 + (size_t)(k & 127) * 128 + ee];
        b3[e] = f2bf(v);
    }
}

DI void phase_mod(unsigned char* smem, const PA& p) {
    float* sv = (float*)smem;
    float* red = sv + 9 * 1024;
    const int tid = tidx(), wid = tid >> 6, lane = tid & 63;
    for (int e = tid; e < 9 * 1024; e += 512) { const int v = e >> 10, k = e & 1023; const float x = v == 0 ? p.in(I_CCTX)[k] : p.in(I_C)[(size_t)(v - 1) * 1024 + k]; sv[e] = siluf(x); }
    __syncthreads();
    float* mod = (float*)(p.ws() + WS_MOD);
    for (int item = bidx(); item < 192; item += gdim()) {
        const int l = item / 96, col0 = (item % 96) * 64;
        const float* w = p.in(I_WADA) + (size_t)l * 1024 * 6144 + col0 + lane;
        float acc[9];
#pragma unroll
        for (int v = 0; v < 9; ++v) acc[v] = 0.f;
        const int kb = wid * 128;
#pragma unroll 16
        for (int k = 0; k < 128; ++k) { const float wv = w[(size_t)(kb + k) * 6144];
#pragma unroll
            for (int v = 0; v < 9; ++v) acc[v] += sv[v * 1024 + kb + k] * wv; }
#pragma unroll
        for (int v = 0; v < 9; ++v) red[(wid * 9 + v) * 64 + lane] = acc[v];
        __syncthreads();
        for (int e = tid; e < 576; e += 512) { const int v = e >> 6, cc = e & 63; float s = p.in(I_BADA)[(size_t)l * 6144 + col0 + cc];
#pragma unroll
            for (int w8 = 0; w8 < 8; ++w8) s += red[(w8 * 9 + v) * 64 + cc];
            mod[((size_t)l * 9 + v) * 6144 + col0 + cc] = s; }
        __syncthreads();
    }
}

DI void phase_norm(const PA& p, int l, int which, bf16_t* Y) {
    const int lane = tidx() & 63, gw = bidx() * 8 + (tidx() >> 6), nw = gdim() * 8;
    const float* g = p.in(which == 1 ? I_GN1 : I_GN2) + (size_t)l * 1024;
    const float* mod = (const float*)(p.ws() + WS_MOD) + (size_t)l * 9 * 6144;
    const float* X = p.out(); const float* xp = p.in(I_XP); const float* xs = p.in(I_XS);
    const bool from_in = (l == 0 && which == 1);
    constexpr int R = 3;
    for (int row0 = gw; row0 < NT; row0 += nw * R) {
        f32x4 x[R][4]; float ss[R];
#pragma unroll
        for (int r = 0; r < R; ++r) { const int row = row0 + r * nw; ss[r] = 0.f;
            if (row < NT) { const float* src = from_in ? (row < NCTX ? xp + (size_t)row * 1024 : xs + (size_t)(row - NCTX) * 1024) : X + (size_t)row * 1024;
#pragma unroll
                for (int i = 0; i < 4; ++i) x[r][i] = *(const f32x4*)(src + lane * 4 + 256 * i); } }
#pragma unroll
        for (int r = 0; r < R; ++r) { const int row = row0 + r * nw; if (row >= NT) continue;
#pragma unroll
            for (int i = 0; i < 4; ++i) ss[r] += x[r][i][0] * x[r][i][0] + x[r][i][1] * x[r][i][1] + x[r][i][2] * x[r][i][2] + x[r][i][3] * x[r][i][3];
            ss[r] = wave_sum(ss[r]); const float rstd = rsqrtf(ss[r] * (1.f / 1024.f) + EPS);
            const float* mv = mod + (size_t)mod_index(row) * 6144 + (which == 1 ? 0 : 3072);
#pragma unroll
            for (int i = 0; i < 4; ++i) { const int c = lane * 4 + 256 * i; const f32x4 gg = *(const f32x4*)(g + c), sh = *(const f32x4*)(mv + c), sc = *(const f32x4*)(mv + 1024 + c);
                const f32x4 y = (x[r][i] * rstd) * gg * (sc + 1.f) + sh; st_bf16x4(Y + (size_t)row * 1024 + c, y); } }
    }
}
DI void phase_final(const PA& p) {
    const int lane = tidx() & 63, gw = bidx() * 8 + (tidx() >> 6), nw = gdim() * 8;
    const float* g = p.in(I_GFIN); float* X = p.out();
    constexpr int R = 3;
    for (int row0 = gw; row0 < NT; row0 += nw * R) {
        f32x4 x[R][4];
#pragma unroll
        for (int r = 0; r < R; ++r) { const int row = row0 + r * nw;
            if (row < NT) {
#pragma unroll
                for (int i = 0; i < 4; ++i) x[r][i] = *(const f32x4*)(X + (size_t)row * 1024 + lane * 4 + 256 * i); } }
#pragma unroll
        for (int r = 0; r < R; ++r) { const int row = row0 + r * nw; if (row >= NT) continue; float ss = 0.f;
#pragma unroll
            for (int i = 0; i < 4; ++i) ss += x[r][i][0] * x[r][i][0] + x[r][i][1] * x[r][i][1] + x[r][i][2] * x[r][i][2] + x[r][i][3] * x[r][i][3];
            ss = wave_sum(ss); const float rstd = rsqrtf(ss * (1.f / 1024.f) + EPS);
#pragma unroll
            for (int i = 0; i < 4; ++i) { const int c = lane * 4 + 256 * i; *(f32x4*)(X + (size_t)row * 1024 + c) = (x[r][i] * rstd) * *(const f32x4*)(g + c); } }
    }
}

DI float rope_inv(int i, float per) { return exp2f(-(float)i * per); }
DI void phase_prep(const PA& p, int l) {
    const int lane = tidx() & 63, gw = bidx() * 8 + (tidx() >> 6), nw = gdim() * 8;
    unsigned char* ws = p.ws();
    const bf16_t* Z1a = (const bf16_t*)(ws + WS_RB); bf16_t* Z1b = (bf16_t*)(ws + WS_RE);
    bf16_t* A2 = (bf16_t*)(ws + WS_RA); bf16_t* A3 = A2 + (size_t)NA2 * 384;
    bf16_t* KR = (bf16_t*)(ws + WS_RF + F_KROPE); bf16_t* CKG = (bf16_t*)(ws + WS_RF + F_CKG); bf16_t* CVG = (bf16_t*)(ws + WS_RF + F_CVG);
    const float* gq = p.in(I_GMQ) + (size_t)l * 256; const float* gkv = p.in(I_GMKV) + (size_t)l * 128;
    const float* wc = p.in(I_WMLC) + (size_t)l * 3 * 512; const float* bc = p.in(I_BMLC) + (size_t)l * 512;
    const float* ggq = p.in(I_GGQ) + (size_t)l * 64; const float* ggk = p.in(I_GGK) + (size_t)l * 64;
    const f32x2* ropem = (const f32x2*)(ws + WS_ROPE); const f32x2* ropeg = ropem + 512;
    for (int row = NT + gw; row < NA2; row += nw) {
        const int b = (row - NT) >> 8, j = (row - NT) & 255; const size_t cr = ((size_t)(b * 2 + l) * 256 + j);
        { unsigned zz = 0u; asm volatile("" : "+v"(zz)); u32x2 z; z.x = zz; z.y = zz; *(u32x2*)(A2 + (size_t)row * 384 + lane * 4) = z; }
        { const float* s_ = p.in(I_CCKV) + cr * 128 + lane * 2; *(unsigned*)(A2 + (size_t)row * 384 + 256 + lane * 2) = cvt_pk_bf16(s_[0], s_[1]); }
        if (lane < 16) { const int half = lane >> 3, i = lane & 7; const float* s_ = p.in(I_CKROPE) + cr * 32 + half * 16; *(unsigned*)(KR + (size_t)row * 32 + half * 16 + 2 * i) = cvt_pk_bf16(s_[i], s_[i + 8]); }
        { const float* s_ = p.in(I_CGK) + cr * 128 + lane * 2; *(unsigned*)(CKG + ((size_t)(b * 256 + j)) * 128 + lane * 2) = cvt_pk_bf16(s_[0], s_[1]); }
        { const float* s_ = p.in(I_CGV) + cr * 128 + lane * 2; *(unsigned*)(CVG + ((size_t)(b * 256 + j)) * 128 + lane * 2) = cvt_pk_bf16(s_[0], s_[1]); }
    }
    { const int j0 = lane * 8; float wv[3][8], bv[8];
#pragma unroll
      for (int j = 0; j < 8; ++j) { bv[j] = bc[j0 + j]; wv[0][j] = wc[j0 + j]; wv[1][j] = wc[512 + j0 + j]; wv[2][j] = wc[1024 + j0 + j]; }
      constexpr int R = 3;
      for (int row0 = gw; row0 < NT; row0 += nw * R) {
          u32x4 uv[R][3];
#pragma unroll
          for (int r = 0; r < R; ++r) { const int t = row0 + r * nw; if (t < NT) { int pos, T; seq_pos(t, pos, T);
#pragma unroll
              for (int d = 0; d < 3; ++d) { const int pp = pos + d - 1; uv[r][d] = (pp >= 0 && pp < T) ? *(const u32x4*)(Z1a + (size_t)(t + d - 1) * 928 + ZC_U + j0) : (u32x4){0u, 0u, 0u, 0u}; } } }
#pragma unroll
          for (int r = 0; r < R; ++r) { const int t = row0 + r * nw; if (t >= NT) continue;
              unsigned o[4];
#pragma unroll
              for (int k = 0; k < 4; ++k) { const unsigned* u0 = (const unsigned*)&uv[r][0]; const unsigned* u1 = (const unsigned*)&uv[r][1]; const unsigned* u2 = (const unsigned*)&uv[r][2];
                  const float c0 = bv[2 * k] + wv[0][2 * k] * bflo(u0[k]) + wv[1][2 * k] * bflo(u1[k]) + wv[2][2 * k] * bflo(u2[k]);
                  const float c1 = bv[2 * k + 1] + wv[0][2 * k + 1] * bfhi(u0[k]) + wv[1][2 * k + 1] * bfhi(u1[k]) + wv[2][2 * k + 1] * bfhi(u2[k]);
                  o[k] = cvt_pk_bf16(siluf(c0), siluf(c1)); }
              *(u32x4*)(A3 + (size_t)t * 512 + j0) = (u32x4){o[0], o[1], o[2], o[3]}; }
      } }
    const f32x4 gq4 = *(const f32x4*)(gq + lane * 4); const float gkv0 = gkv[lane * 2], gkv1 = gkv[lane * 2 + 1];
    const int li = lane & 15, d0 = li * 4;
    const f32x4 ggq4 = *(const f32x4*)(ggq + d0), ggk4 = *(const f32x4*)(ggk + d0);
    constexpr int R2 = 2;
    for (int row0 = gw; row0 < NT; row0 += nw * R2) {
        u32x2 wq[R2], wz[R2][2], wvg[R2]; unsigned wkv[R2], wkr[R2];
#pragma unroll
        for (int r = 0; r < R2; ++r) { const int t = row0 + r * nw; if (t < NT) {
            const bf16_t* z = Z1a + (size_t)t * 928; const bf16_t* zb = Z1b + (size_t)t * 512;
            wq[r] = *(const u32x2*)(z + lane * 4); wkv[r] = *(const unsigned*)(z + 256 + lane * 2);
            wkr[r] = lane < 16 ? ((unsigned)z[384 + (lane >> 3) * 16 + (lane & 7)] | ((unsigned)z[384 + (lane >> 3) * 16 + (lane & 7) + 8] << 16)) : 0u;
            wz[r][0] = *(const u32x2*)(zb + lane * 4); wz[r][1] = lane < 32 ? *(const u32x2*)(zb + 256 + lane * 4) : (u32x2){0u, 0u};
            wvg[r] = (t < NCTX && lane >= 32) ? *(const u32x2*)(zb + 384 + (lane - 32) * 4) : (u32x2){0u, 0u}; } }
#pragma unroll
        for (int r = 0; r < R2; ++r) { const int t = row0 + r * nw; if (t >= NT) continue;
            int pos, T; seq_pos(t, pos, T); const bool ctx = t < NCTX; const int b = ctx ? (t >> 8) : 0;
            const size_t orow = ((size_t)(b * 2 + l) * 256 + pos);
            { float v[4] = {bflo(wq[r].x), bfhi(wq[r].x), bflo(wq[r].y), bfhi(wq[r].y)};
              float ss = v[0] * v[0] + v[1] * v[1] + v[2] * v[2] + v[3] * v[3]; ss = wave_sum(ss); const float rs = rsqrtf(ss * (1.f / 256.f) + EPS);
              st_bf16x4(A2 + (size_t)t * 384 + lane * 4, (f32x4){v[0] * rs * gq4[0], v[1] * rs * gq4[1], v[2] * rs * gq4[2], v[3] * rs * gq4[3]}); }
            { float v0 = bflo(wkv[r]), v1 = bfhi(wkv[r]);
              float ss = wave_sum(v0 * v0 + v1 * v1); const float rs = rsqrtf(ss * (1.f / 128.f) + EPS);
              v0 = v0 * rs * gkv0; v1 = v1 * rs * gkv1;
              *(unsigned*)(A2 + (size_t)t * 384 + 256 + lane * 2) = cvt_pk_bf16(v0, v1);
              if (ctx) { float* o = p.out() + O_CKV + orow * 128 + lane * 2; *(f32x2*)o = (f32x2){v0, v1}; } }
            if (lane < 16) { const int half = lane >> 3, i = lane & 7; float x1 = bflo(wkr[r]), x2 = bfhi(wkr[r]);
              if (ctx) { float* o = p.out() + O_KROPE + orow * 32 + half * 16; o[i] = x1; o[i + 8] = x2; }
              else { const f32x2 tt = ropem[(half ? (pos & 63) : (pos >> 6)) * 8 + i]; const float c = tt.x, sn = tt.y; const float o1 = x1 * c - x2 * sn, o2 = x1 * sn + x2 * c; x1 = o1; x2 = o2; }
              *(unsigned*)(KR + (size_t)t * 32 + half * 16 + 2 * i) = cvt_pk_bf16(x1, x2); }
            bf16_t* zb = Z1b + (size_t)t * 512;
#pragma unroll
            for (int part = 0; part < 2; ++part) {
                const bool act = part == 0 || lane < 32;
                const int off = part * 256 + lane * 4;
                const u32x2 w = wz[r][part];
                float v[4] = {bflo(w.x), bfhi(w.x), bflo(w.y), bfhi(w.y)};
                float ss = v[0] * v[0] + v[1] * v[1] + v[2] * v[2] + v[3] * v[3];
                ss += __shfl_xor(ss, 1); ss += __shfl_xor(ss, 2); ss += __shfl_xor(ss, 4); ss += __shfl_xor(ss, 8);
                const float rs = rsqrtf(ss * (1.f / 64.f) + EPS); const f32x4 gg = part == 0 ? ggq4 : ggk4;
#pragma unroll
                for (int j = 0; j < 4; ++j) v[j] = v[j] * rs * gg[j];
                if (part == 1 && ctx && act) { float* o = p.out() + O_GK + orow * 128 + lane * 4; *(f32x4*)o = (f32x4){v[0], v[1], v[2], v[3]}; }
                if (!ctx) {
                    float pr[4];
#pragma unroll
                    for (int j = 0; j < 4; ++j) pr[j] = __shfl_xor(v[j], 4);
                    const bool isx2 = (li & 4) != 0; const int pq = (li & 8) ? (pos & 63) : (pos >> 6);
#pragma unroll
                    for (int j = 0; j < 4; ++j) { const int i = (d0 + j) & 15; const f32x2 tt = ropeg[pq * 16 + i]; const float c = tt.x, sn = tt.y;
                        v[j] = isx2 ? (pr[j] * sn + v[j] * c) : (v[j] * c - pr[j] * sn); } }
                if (act) st_bf16x4(zb + off, (f32x4){v[0], v[1], v[2], v[3]});
            }
            if (ctx && lane >= 32) { const int c4 = (lane - 32) * 4; *(f32x4*)(p.out() + O_GV + orow * 128 + c4) = (f32x4){bflo(wvg[r].x), bfhi(wvg[r].x), bflo(wvg[r].y), bfhi(wvg[r].y)}; }
        }
    }
}

struct AttnArgs {
    const bf16_t* q; int qs;
    const bf16_t* ka0; const bf16_t* ka1; int kas0, kas1; const bf16_t* kb0; const bf16_t* kb1; int kbs0, kbs1; const bf16_t* v0; const bf16_t* v1; int vs0, vs1;
    int nt1, nt;
    bf16_t* o; int os; float sc;
};
template <int DK> DI void attn_item(unsigned char* smem, const AttnArgs& a) {
    constexpr int KST = DK + 8, CPR = DK / 8, NKS = DK / 32, KBYTES = 64 * KST * 2, BUFB = KBYTES + 64 * 72 * 2;
    const int tid = tidx(), wid = tid >> 6, lane = tid & 63, c = lane & 15, g = lane >> 4;
    bf16x8 qf[2][NKS];
#pragma unroll
    for (int qg = 0; qg < 2; ++qg)
#pragma unroll
        for (int ks = 0; ks < NKS; ++ks) qf[qg][ks] = *(const bf16x8*)(a.q + (size_t)(wid * 32 + qg * 16 + c) * a.qs + ks * 32 + g * 8);
    f32x4 O[4][2]; float mrun[2], lsum[2];
#pragma unroll
    for (int qg = 0; qg < 2; ++qg) { mrun[qg] = -INFINITY; lsum[qg] = 0.f;
#pragma unroll
        for (int db = 0; db < 4; ++db) O[db][qg] = (f32x4){0.f, 0.f, 0.f, 0.f}; }
    bf16x8 kreg[2], vreg[4];
    const int key0 = tid / CPR, cc0 = tid % CPR, key1 = (tid + 512) / CPR, cc1 = (tid + 512) % CPR;
    const bool has1 = DK > 64 && (tid + 512) < 64 * CPR; const bool isv = tid >= 256 && tid < 384; const int vt = tid - 256, sg = vt & 15, e0 = vt >> 4;
    const int vpos = 32 * (sg >> 3) + 8 * (sg & 3) + 4 * ((sg >> 2) & 1);
    const bf16_t* kp0; const bf16_t* kp1; const bf16_t* vp; int kst0, kst1, vst;
    auto rebase = [&](int seg) {
        const bf16_t* ka = seg ? a.ka1 : a.ka0; const bf16_t* kb = seg ? a.kb1 : a.kb0; const int kas = seg ? a.kas1 : a.kas0, kbs = seg ? a.kbs1 : a.kbs0;
        kp0 = cc0 < 8 ? ka + (size_t)key0 * kas + cc0 * 8 : kb + (size_t)key0 * kbs + (cc0 - 8) * 8; kst0 = 64 * (cc0 < 8 ? kas : kbs);
        kp1 = cc1 < 8 ? ka + (size_t)key1 * kas + cc1 * 8 : kb + (size_t)key1 * kbs + (cc1 - 8) * 8; kst1 = 64 * (cc1 < 8 ? kas : kbs);
        vst = seg ? a.vs1 : a.vs0; vp = (seg ? a.v1 : a.v0) + (size_t)(4 * sg) * vst + e0 * 8;
    };
    auto load_tile = [&]() {
        kreg[0] = *(const bf16x8*)kp0; kp0 += kst0;
        if (has1) { kreg[1] = *(const bf16x8*)kp1; kp1 += kst1; }
        if (isv) {
#pragma unroll
            for (int r = 0; r < 4; ++r) vreg[r] = *(const bf16x8*)(vp + (size_t)r * vst);
            vp += (size_t)64 * vst; }
    };
    auto write_tile = [&](int buf) {
        LAS bf16_t* Ks = (LAS bf16_t*)(smem + buf * BUFB); LAS bf16_t* VT = (LAS bf16_t*)(smem + buf * BUFB + KBYTES);
        *(LAS bf16x8*)(Ks + key0 * KST + cc0 * 8) = kreg[0];
        if (has1) *(LAS bf16x8*)(Ks + key1 * KST + cc1 * 8) = kreg[1];
        if (isv) {
#pragma unroll
            for (int j = 0; j < 8; ++j) { u32x2 w; w.x = ((unsigned)(unsigned short)vreg[0][j]) | (((unsigned)(unsigned short)vreg[1][j]) << 16); w.y = ((unsigned)(unsigned short)vreg[2][j]) | (((unsigned)(unsigned short)vreg[3][j]) << 16);
                *(LAS u32x2*)(VT + (e0 * 8 + j) * 72 + vpos) = w; } }
    };
    rebase(0); load_tile(); write_tile(0);
    if (a.nt > 1) { if (a.nt1 == 1) rebase(1); load_tile(); }
    __syncthreads();
    for (int kt = 0; kt < a.nt; ++kt) {
        if (kt + 1 < a.nt) write_tile((kt + 1) & 1);
        if (kt + 2 < a.nt) { if (kt + 2 == a.nt1) rebase(1); load_tile(); }
        const LAS bf16_t* Ks = (const LAS bf16_t*)(smem + (kt & 1) * BUFB); const LAS bf16_t* VT = (const LAS bf16_t*)(smem + (kt & 1) * BUFB + KBYTES);
        bf16x8 kf[NKS][4];
#pragma unroll
        for (int ks = 0; ks < NKS; ++ks)
#pragma unroll
            for (int sb = 0; sb < 4; ++sb) kf[ks][sb] = *(const LAS bf16x8*)(Ks + (16 * sb + c) * KST + ks * 32 + g * 8);
        f32x4 S[2][4];
#pragma unroll
        for (int qg = 0; qg < 2; ++qg)
#pragma unroll
            for (int sb = 0; sb < 4; ++sb) { f32x4 acc = (f32x4){0.f, 0.f, 0.f, 0.f};
#pragma unroll
                for (int ks = 0; ks < NKS; ++ks) acc = __builtin_amdgcn_mfma_f32_16x16x32_bf16(kf[ks][sb], qf[qg][ks], acc, 0, 0, 0);
                S[qg][sb] = acc; }
        bf16x8 vf[2][4];
#pragma unroll
        for (int u = 0; u < 2; ++u)
#pragma unroll
            for (int db = 0; db < 4; ++db) vf[u][db] = *(const LAS bf16x8*)(VT + (16 * db + c) * 72 + 32 * u + 8 * g);
#pragma unroll
        for (int qg = 0; qg < 2; ++qg) {
            float mx = max3f(max3f(S[qg][0][0], S[qg][0][1], S[qg][0][2]), max3f(S[qg][0][3], S[qg][1][0], S[qg][1][1]), max3f(S[qg][1][2], S[qg][1][3], S[qg][2][0]));
            mx = max3f(mx, max3f(S[qg][2][1], S[qg][2][2], S[qg][2][3]), max3f(S[qg][3][0], S[qg][3][1], S[qg][3][2]));
            mx = fmaxf(mx, S[qg][3][3]);
            if (__builtin_amdgcn_ballot_w64((mx - mrun[qg]) * a.sc > 8.f) != 0ull) {
                mx = fmaxf(mx, __shfl_xor(mx, 16)); mx = fmaxf(mx, __shfl_xor(mx, 32));
                const float mn = fmaxf(mrun[qg], mx); const float alpha = exp2raw((mrun[qg] - mn) * a.sc); mrun[qg] = mn;
                lsum[qg] *= alpha;
#pragma unroll
                for (int db = 0; db < 4; ++db) O[db][qg] = O[db][qg] * alpha;
            }
            const float mb = mrun[qg] * a.sc; float ps0 = 0.f, ps1 = 0.f;
            bf16x8 P[2];
#pragma unroll
            for (int sb = 0; sb < 4; ++sb) {
                const float p0 = exp2raw(__builtin_fmaf(S[qg][sb][0], a.sc, -mb)), p1 = exp2raw(__builtin_fmaf(S[qg][sb][1], a.sc, -mb));
                const float p2 = exp2raw(__builtin_fmaf(S[qg][sb][2], a.sc, -mb)), p3 = exp2raw(__builtin_fmaf(S[qg][sb][3], a.sc, -mb));
                S[qg][sb] = (f32x4){p0, p1, p2, p3}; ps0 += p0 + p2; ps1 += p1 + p3; }
            lsum[qg] += ps0 + ps1;
#pragma unroll
            for (int u = 0; u < 2; ++u) { u32x4 w; w.x = cvt_pk_bf16(S[qg][2 * u][0], S[qg][2 * u][1]); w.y = cvt_pk_bf16(S[qg][2 * u][2], S[qg][2 * u][3]);
                w.z = cvt_pk_bf16(S[qg][2 * u + 1][0], S[qg][2 * u + 1][1]); w.w = cvt_pk_bf16(S[qg][2 * u + 1][2], S[qg][2 * u + 1][3]); P[u] = __builtin_bit_cast(bf16x8, w); }
#pragma unroll
            for (int u = 0; u < 2; ++u)
#pragma unroll
                for (int db = 0; db < 4; ++db) O[db][qg] = __builtin_amdgcn_mfma_f32_16x16x32_bf16(vf[u][db], P[u], O[db][qg], 0, 0, 0);
        }
        __syncthreads();
    }
#pragma unroll
    for (int qg = 0; qg < 2; ++qg) {
        float l = lsum[qg]; l += __shfl_xor(l, 16); l += __shfl_xor(l, 32); const float inv = 1.f / l;
#pragma unroll
        for (int db = 0; db < 4; ++db) st_bf16x4(a.o + (size_t)(wid * 32 + qg * 16 + c) * a.os + 16 * db + 4 * g, O[db][qg] * inv);
    }
}

template <int SPLIT> DI void mlstm_item(unsigned char* smem, const PA& p, int l, int seq_is_lat, int b, int h, int dir, int eh) {
    constexpr int ST = 136, NEB = SPLIT ? 4 : 8, NDB = SPLIT ? 4 : 8, EROWS = 16 * NEB;
    LAS bf16_t* Ks = (LAS bf16_t*)smem; LAS bf16_t* KwT = Ks + 128 * ST; LAS bf16_t* VT = KwT + 128 * ST; LAS bf16_t* CT = VT + EROWS * ST;
    LAS float* fv = (LAS float*)(smem + (256 + 2 * EROWS) * ST * 2);
    LAS float* s_bc = fv; LAS float* s_a = fv + 128; LAS float* s_M = fv + 256; LAS float* s_n = fv + 384;
    const int tid = tidx(), wid = tid >> 6, lane = tid & 63, c = lane & 15, g = lane >> 4;
    const int we = SPLIT ? (wid & 3) : wid, wd = SPLIT ? (wid >> 2) : 0;
    unsigned char* ws = p.ws();
    const bf16_t* QK3 = (const bf16_t*)(ws + WS_RB); const bf16_t* Z2 = (const bf16_t*)(ws + WS_RC); const float* gates = (const float*)(ws + WS_RF + F_GATES);
    bf16_t* CAT = (bf16_t*)(ws + WS_RA); bf16_t* HB = (bf16_t*)(ws + WS_W + W_UP);
    const int T = seq_is_lat ? 2048 : 256, nc = T / 128; const int tok0 = seq_is_lat ? NCTX + b * 2048 : b * 256;
    const int e_off = eh * 64;
    f32x4 Cacc[NDB]; float m_prev;
    const size_t sidx = (((size_t)b * 2 + l) * 2 + dir) * 4 + h;
    if (seq_is_lat) {
        const float* c0 = p.in(I_SC) + sidx * 16384;
#pragma unroll
        for (int db = 0; db < NDB; ++db) Cacc[db] = *(const f32x4*)(c0 + (size_t)((NDB * wd + db) * 16 + c) * 128 + e_off + 16 * we + 4 * g);
        if (tid < 128) s_n[tid] = p.in(I_SN)[sidx * 128 + tid];
        m_prev = p.in(I_SM)[sidx];
    } else {
#pragma unroll
        for (int db = 0; db < NDB; ++db) Cacc[db] = (f32x4){0.f, 0.f, 0.f, 0.f};
        if (tid < 128) s_n[tid] = 0.f;
        m_prev = 0.f;
    }
#pragma unroll
    for (int db = 0; db < NDB; ++db)
#pragma unroll
        for (int i = 0; i < 4; ++i) CT[(16 * we + 4 * g + i) * ST + (NDB * wd + db) * 16 + c] = f2bf(Cacc[db][i]);
    bf16x8 kpre[4], vpre[4]; float gpre[4];
    const int sgq = tid & 31, e0q = tid >> 5;
    auto rowof = [&](int ck, int pidx) { const int P = ck * 128 + pidx; return tok0 + (dir == 0 ? P : T - 1 - P); };
    auto load_pre = [&](int ck) {
#pragma unroll
        for (int i = 0; i < 4; ++i) { const int q = tid + 512 * i, s_ = q >> 4, cc = q & 15; kpre[i] = *(const bf16x8*)(QK3 + (size_t)rowof(ck, s_) * 1024 + 512 + h * 128 + cc * 8); }
        if (tid < 64 * NEB) {
#pragma unroll
            for (int r = 0; r < 4; ++r) vpre[r] = *(const bf16x8*)(Z2 + (size_t)rowof(ck, 4 * sgq + r) * 1024 + h * 128 + e_off + e0q * 8); }
        if (wid == 0) {
#pragma unroll
            for (int e = 0; e < 2; ++e) { const float* gr = gates + (size_t)rowof(ck, 2 * lane + e) * 16 + dir * 8 + h; gpre[2 * e] = gr[0]; gpre[2 * e + 1] = gr[4]; } }
    };
    load_pre(0);
    for (int ck = 0; ck < nc; ++ck) {
        if (wid == 0) {
            float li2[2], lf2[2];
#pragma unroll
            for (int e = 0; e < 2; ++e) { li2[e] = gpre[2 * e]; const float f = gpre[2 * e + 1]; lf2[e] = fminf(f, 0.f) - log1pf(__expf(-fabsf(f))); }
            float s1 = lf2[0] + lf2[1], inc = s1;
#pragma unroll
            for (int o = 1; o < 64; o <<= 1) { const float t2 = __shfl_up(inc, o); if (lane >= o) inc += t2; }
            const float ex = inc - s1; const float bc0 = ex + lf2[0], bc1 = ex + s1;
            const float a0 = li2[0] - bc0, a1 = li2[1] - bc1;
            float pm = fmaxf(a0, a1);
#pragma unroll
            for (int o = 1; o < 64; o <<= 1) { const float t2 = __shfl_up(pm, o); if (lane >= o) pm = fmaxf(pm, t2); }
            float pex = __shfl_up(pm, 1); if (lane == 0) pex = -INFINITY;
            s_bc[2 * lane] = bc0; s_bc[2 * lane + 1] = bc1; s_a[2 * lane] = a0; s_a[2 * lane + 1] = a1;
            s_M[2 * lane] = fmaxf(m_prev, fmaxf(pex, a0)); s_M[2 * lane + 1] = fmaxf(m_prev, pm);
        }
#pragma unroll
        for (int i = 0; i < 4; ++i) { const int q = tid + 512 * i, s_ = q >> 4, cc = q & 15; *(LAS bf16x8*)(Ks + s_ * ST + cc * 8) = kpre[i]; }
        const int trow = rowof(ck, 16 * wid + c);
        bf16x8 qf[4];
#pragma unroll
        for (int ks = 0; ks < 4; ++ks) qf[ks] = *(const bf16x8*)(QK3 + (size_t)trow * 1024 + h * 128 + ks * 32 + g * 8);
        __syncthreads();
        const float Mlast = s_M[127]; const float blast = s_bc[127];
        { float wk[4];
#pragma unroll
          for (int r = 0; r < 4; ++r) wk[r] = __expf(s_a[4 * sgq + r] - Mlast);
          bf16x8 kr[4];
#pragma unroll
          for (int r = 0; r < 4; ++r) kr[r] = *(const LAS bf16x8*)(Ks + (4 * sgq + r) * ST + e0q * 8);
#pragma unroll
          for (int j = 0; j < 8; ++j) {
              u32x2 k2; k2.x = cvt_pk_bf16(bf2f((bf16_t)kr[0][j]) * wk[0], bf2f((bf16_t)kr[1][j]) * wk[1]); k2.y = cvt_pk_bf16(bf2f((bf16_t)kr[2][j]) * wk[2], bf2f((bf16_t)kr[3][j]) * wk[3]);
              *(LAS u32x2*)(KwT + (e0q * 8 + j) * ST + 4 * sgq) = k2; }
          if (tid < 64 * NEB) {
#pragma unroll
              for (int j = 0; j < 8; ++j) {
                  u32x2 w; w.x = ((unsigned)(unsigned short)vpre[0][j]) | (((unsigned)(unsigned short)vpre[1][j]) << 16); w.y = ((unsigned)(unsigned short)vpre[2][j]) | (((unsigned)(unsigned short)vpre[3][j]) << 16);
                  *(LAS u32x2*)(VT + (e0q * 8 + j) * ST + 4 * sgq) = w; } } }
        __syncthreads();
        if (ck + 1 < nc) load_pre(ck + 1);
        const int t = 16 * wid + c; const float Mt = s_M[t]; const float inter = __expf(m_prev - Mt);
        bf16x8 Pk[4]; float rowsum = 0.f;
#pragma unroll
        for (int u = 0; u < 4; ++u) {
            f32x4 S0 = (f32x4){0.f, 0.f, 0.f, 0.f}, S1 = S0;
#pragma unroll
            for (int ks = 0; ks < 4; ++ks) {
                const int k0 = 32 * u + 8 * (c >> 2) + (c & 3);
                const bf16x8 a0 = *(const LAS bf16x8*)(Ks + k0 * ST + ks * 32 + g * 8); const bf16x8 a1 = *(const LAS bf16x8*)(Ks + (k0 + 4) * ST + ks * 32 + g * 8);
                S0 = __builtin_amdgcn_mfma_f32_16x16x32_bf16(a0, qf[ks], S0, 0, 0, 0); S1 = __builtin_amdgcn_mfma_f32_16x16x32_bf16(a1, qf[ks], S1, 0, 0, 0);
            }
            float w8[8];
#pragma unroll
            for (int i = 0; i < 4; ++i) { const int s0 = 32 * u + 8 * g + i, s1 = s0 + 4;
                w8[i] = s0 <= t ? S0[i] * __expf(s_a[s0] - Mt) : 0.f; w8[4 + i] = s1 <= t ? S1[i] * __expf(s_a[s1] - Mt) : 0.f; }
#pragma unroll
            for (int i = 0; i < 8; ++i) rowsum += w8[i];
            u32x4 w; w.x = cvt_pk_bf16(w8[0], w8[1]); w.y = cvt_pk_bf16(w8[2], w8[3]); w.z = cvt_pk_bf16(w8[4], w8[5]); w.w = cvt_pk_bf16(w8[6], w8[7]); Pk[u] = __builtin_bit_cast(bf16x8, w);
        }
        rowsum += __shfl_xor(rowsum, 16); rowsum += __shfl_xor(rowsum, 32);
        float qn = 0.f;
#pragma unroll
        for (int ks = 0; ks < 4; ++ks)
#pragma unroll
            for (int j = 0; j < 8; ++j) qn += bf2f((bf16_t)qf[ks][j]) * s_n[ks * 32 + g * 8 + j];
        qn += __shfl_xor(qn, 16); qn += __shfl_xor(qn, 32);
        const float den = rowsum + inter * qn; const float dnm = fmaxf(fabsf(den), __expf(-(s_bc[t] + Mt))); const float rden = 1.f / dnm;
        bf16_t* orow = dir == 0 ? CAT + (size_t)trow * 1024 + 256 + h * 128 + e_off : HB + (size_t)trow * 512 + h * 128 + e_off;
#pragma unroll
        for (int eb = 0; eb < NEB; ++eb) { f32x4 n4 = (f32x4){0.f, 0.f, 0.f, 0.f};
#pragma unroll
            for (int ks = 0; ks < 4; ++ks) { const bf16x8 af = *(const LAS bf16x8*)(CT + (16 * eb + c) * ST + ks * 32 + g * 8); n4 = __builtin_amdgcn_mfma_f32_16x16x32_bf16(af, qf[ks], n4, 0, 0, 0); }
            n4 = n4 * inter;
#pragma unroll
            for (int u = 0; u < 4; ++u) { const bf16x8 af = *(const LAS bf16x8*)(VT + (16 * eb + c) * ST + 32 * u + 8 * g); n4 = __builtin_amdgcn_mfma_f32_16x16x32_bf16(af, Pk[u], n4, 0, 0, 0); }
            st_bf16x4(orow + 16 * eb + 4 * g, n4 * rden); }
        const float decay = __expf(m_prev - Mlast);
        { bf16x8 af[4];
#pragma unroll
          for (int u = 0; u < 4; ++u) af[u] = *(const LAS bf16x8*)(VT + (16 * we + c) * ST + 32 * u + 8 * g);
#pragma unroll
          for (int db = 0; db < NDB; ++db) { f32x4 cc = Cacc[db] * decay;
#pragma unroll
              for (int u = 0; u < 4; ++u) { const bf16x8 bfr = *(const LAS bf16x8*)(KwT + (16 * (NDB * wd + db) + c) * ST + 32 * u + 8 * g); cc = __builtin_amdgcn_mfma_f32_16x16x32_bf16(af[u], bfr, cc, 0, 0, 0); }
              Cacc[db] = cc; } }
        float nnew = 0.f;
        if (tid < 128) { float sacc = 0.f;
#pragma unroll 4
            for (int s8 = 0; s8 < 16; ++s8) { const bf16x8 kk = *(const LAS bf16x8*)(KwT + tid * ST + s8 * 8);
#pragma unroll
                for (int j = 0; j < 8; ++j) sacc += bf2f((bf16_t)kk[j]); }
            nnew = decay * s_n[tid] + sacc; }
        m_prev = blast + Mlast;
        __syncthreads();
        if (tid < 128) s_n[tid] = nnew;
#pragma unroll
        for (int db = 0; db < NDB; ++db)
#pragma unroll
            for (int i = 0; i < 4; ++i) CT[(16 * we + 4 * g + i) * ST + (NDB * wd + db) * 16 + c] = f2bf(Cacc[db][i]);
    }
    __syncthreads();
    if (!seq_is_lat) {
        float* co = p.out() + O_C + sidx * 16384;
#pragma unroll
        for (int db = 0; db < NDB; ++db) *(f32x4*)(co + (size_t)((NDB * wd + db) * 16 + c) * 128 + e_off + 16 * we + 4 * g) = Cacc[db];
        if (eh == 0) { if (tid < 128) p.out()[O_N + sidx * 128 + tid] = s_n[tid];
                       if (tid == 0) p.out()[O_M + sidx] = m_prev; }
    }
    __syncthreads();
}

DI void phase_hn(const PA& p, int l) {
    const int lane = tidx() & 63, gw = bidx() * 8 + (tidx() >> 6), nw = gdim() * 8;
    unsigned char* ws = p.ws();
    bf16_t* CAT = (bf16_t*)(ws + WS_RA); const bf16_t* HB = (const bf16_t*)(ws + WS_W + W_UP); const bf16_t* Z2 = (const bf16_t*)(ws + WS_RC);
    const float* gout = p.in(I_GMLOUT) + (size_t)l * 512 + lane * 8;
    f32x4 g0 = *(const f32x4*)gout, g1 = *(const f32x4*)(gout + 4);
    constexpr int R = 4;
    for (int row0 = gw; row0 < NT; row0 += nw * R) {
        u32x4 a[R], b[R], o[R];
#pragma unroll
        for (int r = 0; r < R; ++r) { const int row = row0 + r * nw; if (row < NT) {
            a[r] = *(const u32x4*)(CAT + (size_t)row * 1024 + 256 + lane * 8); b[r] = *(const u32x4*)(HB + (size_t)row * 512 + lane * 8); o[r] = *(const u32x4*)(Z2 + (size_t)row * 1024 + 512 + lane * 8); } }
#pragma unroll
        for (int r = 0; r < R; ++r) { const int row = row0 + r * nw; if (row >= NT) continue;
            float v[8] = {bflo(a[r].x) + bflo(b[r].x), bfhi(a[r].x) + bfhi(b[r].x), bflo(a[r].y) + bflo(b[r].y), bfhi(a[r].y) + bfhi(b[r].y), bflo(a[r].z) + bflo(b[r].z), bfhi(a[r].z) + bfhi(b[r].z), bflo(a[r].w) + bflo(b[r].w), bfhi(a[r].w) + bfhi(b[r].w)};
            float ss = 0.f;
#pragma unroll
            for (int j = 0; j < 8; ++j) ss += v[j] * v[j];
            ss += __shfl_xor(ss, 1); ss += __shfl_xor(ss, 2); ss += __shfl_xor(ss, 4); ss += __shfl_xor(ss, 8);
            const float rs = rsqrtf(ss * (1.f / 128.f) + EPS);
            const float og[8] = {bflo(o[r].x), bfhi(o[r].x), bflo(o[r].y), bfhi(o[r].y), bflo(o[r].z), bfhi(o[r].z), bflo(o[r].w), bfhi(o[r].w)};
            const float gg[8] = {g0[0], g0[1], g0[2], g0[3], g1[0], g1[1], g1[2], g1[3]};
#pragma unroll
            for (int j = 0; j < 8; ++j) v[j] = v[j] * rs * gg[j] * sigmoidf(og[j]);
            u32x4 w; w.x = cvt_pk_bf16(v[0], v[1]); w.y = cvt_pk_bf16(v[2], v[3]); w.z = cvt_pk_bf16(v[4], v[5]); w.w = cvt_pk_bf16(v[6], v[7]);
            *(u32x4*)(CAT + (size_t)row * 1024 + 256 + lane * 8) = w; }
    }
}

DI void phase_mixers(unsigned char* smem, const PA& p, int l, int rep) {
    unsigned char* ws = p.ws();
    unsigned* ctr = (unsigned*)(ws + WS_CTRL) + 64 * (1 + l + 2 * rep);
    LAS int* s_item = (LAS int*)(smem + LDS_BYTES - 64);
    const bf16_t* QMLA = (const bf16_t*)(ws + WS_RF + F_QMLA); const bf16_t* KV = (const bf16_t*)(ws + WS_RF + F_KVMLA); const bf16_t* KR = (const bf16_t*)(ws + WS_RF + F_KROPE);
    const bf16_t* Z1b = (const bf16_t*)(ws + WS_RE); const bf16_t* CKG = (const bf16_t*)(ws + WS_RF + F_CKG); const bf16_t* CVG = (const bf16_t*)(ws + WS_RF + F_CVG);
    bf16_t* CAT = (bf16_t*)(ws + WS_RA);
    for (;;) {
        __syncthreads();
        if (tidx() == 0) *s_item = (int)atomicAdd(ctr, 1u);
        __syncthreads();
        const int it = *s_item;
        if (it >= 1088) break;
        if (it < 64) { mlstm_item<0>(smem, p, l, 1, it >> 3, (it >> 1) & 3, it & 1, 0); continue; }
        if (it >= 576 && it < 832) { const int j = it - 576; mlstm_item<0>(smem, p, l, 0, j >> 3, (j >> 1) & 3, j & 1, 0); continue; }
        int lat, kind, b, h, qb;
        if (it < 576) { const int j = it - 64; lat = 1; kind = j >> 8; const int r = j & 255; b = r >> 5; h = (r >> 3) & 3; qb = r & 7; }
        else { const int j = it - 832; lat = 0; kind = j >> 7; const int r = j & 127; b = r >> 2; h = r & 3; qb = 0; }
        const int tok0 = lat ? NCTX + b * 2048 : b * 256; const int q0 = tok0 + qb * 256;
        AttnArgs a;
        a.nt1 = lat ? 32 : 4; a.nt = lat ? 36 : 4;
        if (kind == 0) {
            a.q = QMLA + (size_t)q0 * 384 + h * 96; a.qs = 384;
            a.ka0 = KV + (size_t)tok0 * 512 + h * 128; a.kas0 = 512; a.kb0 = KR + (size_t)tok0 * 32; a.kbs0 = 32; a.v0 = KV + (size_t)tok0 * 512 + h * 128 + 64; a.vs0 = 512;
            const size_t cr = (size_t)NT + b * 256;
            a.ka1 = KV + cr * 512 + h * 128; a.kas1 = 512; a.kb1 = KR + cr * 32; a.kbs1 = 32; a.v1 = KV + cr * 512 + h * 128 + 64; a.vs1 = 512;
            a.o = CAT + (size_t)q0 * 1024 + h * 64; a.os = 1024; a.sc = 0.10206207261596577f * LOG2E;
            attn_item<96>(smem, a);
#if PROBE == 6
            attn_item<96>(smem, a);
#endif
        } else {
            const int kvh = h >> 1;
            a.q = Z1b + (size_t)q0 * 512 + h * 64; a.qs = 512;
            a.ka0 = Z1b + (size_t)tok0 * 512 + 256 + kvh * 64; a.kas0 = 512; a.kb0 = a.ka0; a.kbs0 = 512; a.v0 = Z1b + (size_t)tok0 * 512 + 384 + kvh * 64; a.vs0 = 512;
            a.ka1 = CKG + (size_t)b * 256 * 128 + kvh * 64; a.kas1 = 128; a.kb1 = a.ka1; a.kbs1 = 128; a.v1 = CVG + (size_t)b * 256 * 128 + kvh * 64; a.vs1 = 128;
            a.o = CAT + (size_t)q0 * 1024 + 768 + h * 64; a.os = 1024; a.sc = 0.125f * LOG2E;
            attn_item<64>(smem, a);
#if PROBE == 6
            attn_item<64>(smem, a);
#endif
        }
    }
}

DI void phase_ffix(const PA& p, int l, const float* GB, const float* AB, bf16_t* H) {
    const float* wc = p.in(I_WFC) + (size_t)l * 3 * 2816; const float* bc = p.in(I_BFC) + (size_t)l * 2816;
    const int total = 384 * 2 * 704;
    for (int e = bidx() * 512 + tidx(); e < total; e += gdim() * 512) {
        const int j = (e % 704) * 4, gr = e / 704, G = gr >> 1, hi = gr & 1;
        const int r = G * 64 + (hi ? 63 : 0); int pos, T; seq_pos(r, pos, T);
        const f32x4 zero = (f32x4){0.f, 0.f, 0.f, 0.f};
        f32x4 gp, gc, gn;
        if (!hi) { gp = pos > 0 ? *(const f32x4*)(GB + ((size_t)(G - 1) * 4 + 3) * 2816 + j) : zero; gc = *(const f32x4*)(GB + ((size_t)G * 4 + 0) * 2816 + j); gn = *(const f32x4*)(GB + ((size_t)G * 4 + 1) * 2816 + j); }
        else     { gp = *(const f32x4*)(GB + ((size_t)G * 4 + 2) * 2816 + j); gc = *(const f32x4*)(GB + ((size_t)G * 4 + 3) * 2816 + j); gn = pos < T - 1 ? *(const f32x4*)(GB + ((size_t)(G + 1) * 4 + 0) * 2816 + j) : zero; }
        const f32x4 a4 = *(const f32x4*)(AB + ((size_t)G * 2 + hi) * 2816 + j);
        const f32x4 w0 = *(const f32x4*)(wc + j), w1 = *(const f32x4*)(wc + 2816 + j), w2 = *(const f32x4*)(wc + 2 * 2816 + j), bb = *(const f32x4*)(bc + j);
        f32x4 o;
#pragma unroll
        for (int i = 0; i < 4; ++i) o[i] = siluf(bb[i] + w0[i] * gp[i] + w1[i] * gc[i] + w2[i] * gn[i]) * a4[i];
        st_bf16x4(H + (size_t)r * 2816 + j, o);
    }
}

constexpr int NPHASE = 24, PPL = 11;
DI int probe_reps(int ph) {
    if (ph == 0 || ph == NPHASE - 1) return 1;
    const int q = (ph - 1) % PPL;
    if (PROBE == 1) return q == 4 ? 2 : 1;
    if (PROBE == 2) return (q == 1 || q == 3 || q == 8) ? 2 : 1;
    if (PROBE == 4) return (q == 0 || q == 7 || q == 9) ? 2 : 1;
    if (PROBE == 8) return q == 1 ? 2 : 1;
    if (PROBE == 9) return q == 8 ? 2 : 1;
    if (PROBE == 10) return q == 3 ? 2 : 1;
    if (PROBE == 11) return q == 2 ? 1 : (q == 5 ? 2 : 1);
    return 1;
}
DI void run_phase(unsigned char* smem, const PA& p, int ph, int rep) {
    unsigned char* ws = p.ws();
    if (ph == 0) {
        if (bidx() == 0) for (int i = tidx(); i < 5120; i += 512) ((unsigned*)(ws + WS_CTRL))[i] = 0u;
        if (bidx() == gdim() - 1) {
            f32x2* tm = (f32x2*)(ws + WS_ROPE); f32x2* tg = tm + 512;
            for (int e = tidx(); e < 1536; e += 512) { const bool m = e < 512; const int ee = m ? e : e - 512; const int pos = m ? ee >> 3 : ee >> 4, i = m ? ee & 7 : ee & 15;
                float sn, cs; sincosf((float)pos * exp2f(-(float)i * (13.287712379549449f / (m ? 8.f : 16.f))), &sn, &cs); (m ? tm : tg)[ee] = (f32x2){cs, sn}; }
        }
        phase_mod(smem, p);
        convert_weights(smem, p, 0, bidx(), gdim());
        return;
    }
    if (ph == NPHASE - 1) { phase_final(p); return; }
    int l = (ph - 1) / PPL, q = (ph - 1) % PPL;
    asm volatile("" : "+s"(l), "+s"(q));
    unsigned char* W = ws + WS_W;
    const float* mod = (const float*)(ws + WS_MOD);
    bf16_t* RA = (bf16_t*)(ws + WS_RA); bf16_t* RB = (bf16_t*)(ws + WS_RB); bf16_t* RC = (bf16_t*)(ws + WS_RC); bf16_t* RE = (bf16_t*)(ws + WS_RE);
    bf16_t* H = RB; float* GB = (float*)(ws + WS_RB + (size_t)NT * 2816 * 2); float* AB = GB + (size_t)384 * 4 * 2816;
    switch (q) {
    case 0: phase_norm(p, l, 1, RA); break;
    case 1: { EpiIn e; e.z1a = RB; e.z2 = RC; e.z1b = RE; e.gates = (float*)(ws + WS_RF + F_GATES); e.bg = p.in(I_BGATES) + (size_t)l * 16;
              run_gemm(smem, RA, (const bf16_t*)(W + W_IN), NT, 2560, 1024, e); } break;
    case 2:
#ifndef NO_PREP
        phase_prep(p, l);
#endif
        break;
    case 3: { EpiA2 e; e.qmla = (bf16_t*)(ws + WS_RF + F_QMLA); e.kvmla = (bf16_t*)(ws + WS_RF + F_KVMLA); e.rope = (const f32x2*)(ws + WS_ROPE);
              run_gemm(smem, RA, (const bf16_t*)(W + W_B2), NA2, 1024, 384, e); }
            { EpiA3 e; e.qk3 = RB;
              run_gemm(smem, RA + (size_t)NA2 * 384, (const bf16_t*)(W + W_B3), NT, 1024, 512, e); } break;
    case 4:
#ifndef NO_MIX
        phase_mixers(smem, p, l, rep);
#endif
        break;
    case 5: phase_hn(p, l); break;
    case 6: { EpiRes e; e.src0 = l == 0 ? p.in(I_XP) : p.out(); e.src1 = l == 0 ? p.in(I_XS) : p.out() + (size_t)NCTX * 1024; e.dst = p.out(); e.gate = mod + (size_t)l * 9 * 6144 + 2048;
              run_gemm(smem, RA, (const bf16_t*)(W + W_OUT), NT, 1024, 1024, e);
              { const int fi = gemm_first_idle(NT, 1024); if (bidx() >= fi) convert_weights_b(smem, p, l, 0, bidx() - fi, gdim() - fi); else if (fi == gdim()) convert_weights_b(smem, p, l, 0, bidx(), gdim()); } } break;
    case 7: convert_weights_b(smem, p, l, 1, bidx(), gdim()); phase_norm(p, l, 2, RA); break;
    case 8: { EpiUp e; e.H = H; e.GB = GB; e.AB = AB; e.wc = p.in(I_WFC) + (size_t)l * 3 * 2816; e.bc = p.in(I_BFC) + (size_t)l * 2816;
              run_gemm(smem, RA, (const bf16_t*)(W + W_UP), NT, 5632, 1024, e);
              if (l == 0) { const int fi = gemm_first_idle(NT, 5632); if (bidx() >= fi) convert_weights(smem, p, 1, bidx() - fi, gdim() - fi); else if (fi == gdim()) convert_weights(smem, p, 1, bidx(), gdim()); } } break;
    case 9: phase_ffix(p, l, GB, AB, H); break;
    default: { EpiRes e; e.src0 = p.out(); e.src1 = p.out() + (size_t)NCTX * 1024; e.dst = p.out(); e.gate = mod + (size_t)l * 9 * 6144 + 5120;
               run_gemm(smem, H, (const bf16_t*)(W + W_DN), NT, 1024, 2816, e); } break;
    }
}
__global__ void __launch_bounds__(512, 2) fwd_megakernel(Params p) {
    extern __shared__ __attribute__((aligned(16))) unsigned char smem[];
    cg::grid_group grid = cg::this_grid();
    typedef const __attribute__((address_space(4))) Params* CParams;
    volatile LAS unsigned* st = (volatile LAS unsigned*)(smem + LDS_BYTES - 32);
    XcdBarrier xb; xb.bar = nullptr; xb.x = 0; xb.st = st;
    int redo = 0;
    for (int ph = 0; ph < NPHASE; ++ph) {
#if PROBE == 11
        if (ph > 0 && ph < NPHASE - 1) { const int q = (ph - 1) % PPL; if (q == 3) { if (!redo) { redo = 1; ph -= 2; } else redo = 0; } }
#endif
        for (int rep = 0; rep < probe_reps(ph); ++rep) {
            CParams pp = (CParams)__builtin_amdgcn_kernarg_segment_ptr();
            asm volatile("" : "+s"(pp));
            PA q; q.pp = pp;
            run_phase(smem, q, ph, rep);
            if (ph == 0) {
                grid.sync();
                if (tidx() == 0) { st[0] = 0u; st[1] = 0u; }
                __syncthreads();
                xb = xcd_barrier_post((unsigned*)(q.ws() + WS_BAR), st);
            } else if (ph + 1 < NPHASE) {
                xcd_barrier(xb);
#if PROBE == 3
                xcd_barrier(xb);
#endif
            }
        }
    }
}

extern "C" void kernel_launch(void* const* d_in, const int* in_sizes, int n_in, void* d_out, int out_size, void* d_ws, size_t ws_size, hipStream_t stream) {
    static int grid_blocks = 0;
    if (grid_blocks == 0) {
        if (n_in != N_IN || ws_size < WS_END) { fprintf(stderr, "kernel_launch: unexpected n_in %d or ws_size %zu (need %zu)\n", n_in, ws_size, (size_t)WS_END); grid_blocks = -1; return; }
        int dev = 0, cus = 0, per_cu = 0;
        hipGetDevice(&dev);
        hipDeviceGetAttribute(&cus, hipDeviceAttributeMultiprocessorCount, dev);
        if (hipFuncSetAttribute((const void*)fwd_megakernel, hipFuncAttributeMaxDynamicSharedMemorySize, LDS_BYTES) != hipSuccess) { fprintf(stderr, "kernel_launch: hipFuncSetAttribute failed\n"); grid_blocks = -1; return; }
        hipOccupancyMaxActiveBlocksPerMultiprocessor(&per_cu, (const void*)fwd_megakernel, 512, LDS_BYTES);
        if (per_cu < 1) { fprintf(stderr, "kernel_launch: occupancy query reports %d blocks per CU\n", per_cu); per_cu = 1; }
        grid_blocks = cus;
    }
    if (grid_blocks < 0) return;
    Params p{};
    for (int i = 0; i < N_IN; ++i) p.in[i] = (const float*)d_in[i];
    p.out = (float*)d_out; p.ws = (unsigned char*)d_ws;
    void* args[] = {&p};
    hipError_t e = hipLaunchCooperativeKernel((const void*)fwd_megakernel, dim3(grid_blocks), dim3(512), args, LDS_BYTES, stream);
    if (e != hipSuccess) fprintf(stderr, "cooperative launch failed: %s (grid %d)\n", hipGetErrorString(e), grid_blocks);
}
```

```cpp
#include <hip/hip_runtime.h>
#include <hip/hip_cooperative_groups.h>
#include <cstdio>
namespace cg = cooperative_groups;

#ifndef PROBE
#define PROBE 0
#endif
#ifndef STAGGER
#define STAGGER 0
#endif
#define DI __device__ __forceinline__
#define LAS __attribute__((address_space(3)))
typedef unsigned short bf16_t;
typedef short bf16x8 __attribute__((ext_vector_type(8)));
typedef float f32x4 __attribute__((ext_vector_type(4)));
typedef unsigned u32x4 __attribute__((ext_vector_type(4)));
typedef unsigned u32x2 __attribute__((ext_vector_type(2)));

constexpr int NT = 24576, NCTX = 8192, NA2 = 26624;
constexpr float EPS = 1e-6f;
constexpr float LOG2E = 1.4426950408889634f;
constexpr int ZC_U = 416, ZC_VML = 928, ZC_GATES = 1952, ZC_QG = 1968, ZC_END = 2480;
enum { I_XP = 0, I_XS, I_CCKV, I_CKROPE, I_CGK, I_CGV, I_SC, I_SN, I_SM, I_C, I_CCTX, I_WADA, I_BADA, I_GN1, I_GN2, I_WIN, I_GMQ, I_WUQ, I_GMKV, I_WUKV,
       I_WMLC, I_BMLC, I_WMLQ, I_WMLK, I_BGATES, I_GMLOUT, I_GGQ, I_GGK, I_WOUT, I_WUP, I_WFC, I_BFC, I_WDN, I_GFIN, N_IN };
constexpr size_t O_X = 0, O_CKV = 25165824, O_KROPE = 27262976, O_GK = 27787264, O_GV = 29884416, O_C = 31981568, O_N = 40370176, O_M = 40435712;
constexpr size_t WS_CTRL = 0, WS_BAR = 4096, WS_ROPE = 20480, WS_MOD = 32768, WS_W = WS_MOD + 442368;
constexpr size_t W_IN = 0, W_B2 = W_IN + 5242880, W_B3 = W_B2 + 786432, W_OUT = W_B3 + 1048576, W_UP = W_OUT + 2097152, W_DN = W_UP + 11534336, W_SZ = W_UP + 25165824;
constexpr size_t WS_RA = WS_W + W_SZ, RSZ = 50331648;
constexpr size_t WS_RB = WS_RA + RSZ, WS_RC = WS_RB + RSZ, WS_RE = WS_RC + RSZ, WS_RF = WS_RE + 25165824;
constexpr size_t F_GATES = 0, F_CKG = F_GATES + 1572864, F_CVG = F_CKG + 524288, F_KROPE = F_CVG + 524288, F_QMLA = F_KROPE + 1703936, F_KVMLA = F_QMLA + 18874368, F_SZ = F_KVMLA + 27262976;
constexpr size_t WS_END = WS_RF + F_SZ;
static_assert(WS_END <= 268435456ull, "workspace over 256 MiB");
static_assert(WS_RB + (size_t)NT * 2816 * 2 + (size_t)384 * 6 * 2816 * 4 <= WS_END, "FFN buffers overflow");
constexpr int LDS_BYTES = 147456;

struct Params { const float* in[N_IN]; float* out; unsigned char* ws; };
struct PA { const __attribute__((address_space(4))) Params* pp;
    __device__ __forceinline__ const float* in(int i) const { return pp->in[i]; }
    __device__ __forceinline__ float* out() const { return pp->out; }
    __device__ __forceinline__ unsigned char* ws() const { return pp->ws; } };

DI int tidx() { int t = __builtin_amdgcn_workitem_id_x(); asm volatile("" : "+v"(t)); return t; }
DI int bidx() { int b = __builtin_amdgcn_workgroup_id_x(); asm volatile("" : "+s"(b)); return b; }
DI int gdim() { int g = (int)__ockl_get_num_groups(0); asm volatile("" : "+s"(g)); return g; }
typedef float f32x2 __attribute__((ext_vector_type(2)));
typedef __bf16 bf16x2v __attribute__((ext_vector_type(2)));
DI unsigned cvt_pk_bf16(float lo, float hi) { const f32x2 v = {lo, hi}; return __builtin_bit_cast(unsigned, __builtin_convertvector(v, bf16x2v)); }
DI float bf2f(bf16_t b) { return __uint_as_float(((unsigned)b) << 16); }
DI float bflo(unsigned u) { return __uint_as_float(u << 16); }
DI float bfhi(unsigned u) { return __uint_as_float(u & 0xffff0000u); }
DI bf16_t f2bf(float f) { return (bf16_t)(cvt_pk_bf16(f, 0.f) & 0xffffu); }
DI float max3f(float a, float b, float c) { return fmaxf(fmaxf(a, b), c); }
DI float exp2raw(float x) { return __builtin_amdgcn_exp2f(x); }
DI float wave_sum(float v) { for (int o = 32; o >= 1; o >>= 1) v += __shfl_xor(v, o); return v; }
DI float sigmoidf(float x) { return __builtin_amdgcn_rcpf(1.f + __builtin_amdgcn_exp2f(-LOG2E * x)); }
DI float siluf(float x) { return x * sigmoidf(x); }
DI float row_prev(float v) { return __builtin_bit_cast(float, __builtin_amdgcn_update_dpp(0, __builtin_bit_cast(int, v), 0x121, 0xf, 0xf, false)); }
DI float row_next(float v) { return __builtin_bit_cast(float, __builtin_amdgcn_update_dpp(0, __builtin_bit_cast(int, v), 0x12f, 0xf, 0xf, false)); }
DI float row_shr1(float edge, float v) { return __builtin_bit_cast(float, __builtin_amdgcn_update_dpp(__builtin_bit_cast(int, edge), __builtin_bit_cast(int, v), 0x111, 0xf, 0xf, false)); }
DI float row_shl1(float edge, float v) { return __builtin_bit_cast(float, __builtin_amdgcn_update_dpp(__builtin_bit_cast(int, edge), __builtin_bit_cast(int, v), 0x101, 0xf, 0xf, false)); }
DI int mod_index(int row) { return row < NCTX ? 0 : 1 + ((row - NCTX) >> 11); }
DI void seq_pos(int t, int& pos, int& T) { if (t < NCTX) { pos = t & 255; T = 256; } else { pos = (t - NCTX) & 2047; T = 2048; } }


#define XB_TMO      128
#define XB_XCNT(j)  (256  + 64 * (j))
#define XB_XSUB(j)  (1280 + 64 * (j))
#define XB_XGEN(j)  (2304 + 64 * (j))
#define XB_TOP      3328
#define XB_TOPGEN   3392
#define XCD_BAR_WORDS 3456
#define XB_SPIN_CAP (1u << 18)
DI unsigned xb_ld(unsigned* p)              { return __hip_atomic_load(p, __ATOMIC_RELAXED, __HIP_MEMORY_SCOPE_AGENT); }
DI unsigned xb_add(unsigned* p, unsigned v) { return __hip_atomic_fetch_add(p, v, __ATOMIC_RELAXED, __HIP_MEMORY_SCOPE_AGENT); }
DI unsigned xb_xcc_id() { return (unsigned)__builtin_amdgcn_s_getreg((3 << 11) | 20) & 0xFu; }
#define XB_SPIN(cond, bar) do { unsigned _sp = 0; while (cond) { __builtin_amdgcn_s_sleep(1); \
    if ((++_sp & 255u) == 0u) { if (xb_ld(&(bar)[XB_TMO])) break; if (_sp > XB_SPIN_CAP) { atomicAdd(&(bar)[XB_TMO], 1u); break; } } } } while (0)
struct XcdBarrier { unsigned* bar; unsigned x; volatile LAS unsigned* st; };
DI XcdBarrier xcd_barrier_post(unsigned* bar, volatile LAS unsigned* st) {
    XcdBarrier b; b.bar = bar; b.x = xb_xcc_id(); b.st = st;
    if (tidx() == 0) (void)xb_add(&bar[XB_XCNT(b.x)], 1u);
    return b;
}
DI void xcd_barrier_complete(unsigned* bar, unsigned x, unsigned& nloc, unsigned& nx) {
    const unsigned G = (unsigned)gdim();
    unsigned sum, cnt, mine, sp = 0u;
    for (;;) {
        sum = 0u; cnt = 0u; mine = 0u;
#pragma unroll
        for (unsigned j = 0; j < 16; ++j) { const unsigned c = xb_ld(&bar[XB_XCNT(j)]); sum += c; cnt += (c > 0u) ? 1u : 0u; mine = (j == x) ? c : mine; }
        if (sum == G) break;
        __builtin_amdgcn_s_sleep(1);
        if ((++sp & 255u) == 0u) { if (xb_ld(&bar[XB_TMO])) break; if (sp > XB_SPIN_CAP) { atomicAdd(&bar[XB_TMO], 1u); break; } }
    }
    nloc = mine > 0u ? mine : 1u; nx = cnt > 0u ? cnt : 1u;
}
DI void xcd_barrier(const XcdBarrier& b) {
    asm volatile("s_waitcnt vmcnt(0)" ::: "memory");
    __syncthreads();
    if (tidx() == 0) {
        unsigned* bar = b.bar;
        __builtin_amdgcn_s_waitcnt(0);
        unsigned nloc = b.st[0], nx = b.st[1];
        if (nloc == 0u) { xcd_barrier_complete(bar, b.x, nloc, nx); b.st[0] = nloc; b.st[1] = nx; }
        const unsigned old = xb_add(&bar[XB_XSUB(b.x)], 1u);
        const unsigned gen = old / nloc;
        if (old + 1u == (gen + 1u) * nloc) {
            __builtin_amdgcn_fence(__ATOMIC_RELEASE, "agent");
            asm volatile("s_waitcnt vmcnt(0)" ::: "memory");
            const unsigned og = xb_add(&bar[XB_TOP], 1u);
            const unsigned tg = og / nx;
            if (og + 1u == (tg + 1u) * nx) xb_add(&bar[XB_TOPGEN], 1u);
            else XB_SPIN(xb_ld(&bar[XB_TOPGEN]) == tg, bar);
            __builtin_amdgcn_fence(__ATOMIC_ACQUIRE, "agent");
            xb_add(&bar[XB_XGEN(b.x)], 1u);
            asm volatile("s_waitcnt vmcnt(0)" ::: "memory");
        } else {
            XB_SPIN(xb_ld(&bar[XB_XGEN(b.x)]) == gen, bar);
            __builtin_amdgcn_fence(__ATOMIC_ACQUIRE, "agent");
            asm volatile("s_waitcnt vmcnt(0)" ::: "memory");
        }
    }
    __syncthreads();
}

namespace pg8 {
constexpr int BM = 256, BK = 64, HALF = 128, HTB = HALF * BK * 2, STAGE_BYTES = 8 * HTB, NXCD = 8, WGM = 4;
DI int lds_byte(int r, int c) { const int st = (r >> 4) * 2 + (c >> 5), rr = r & 15, cc = c & 31, ob = rr * 64 + cc * 2; return st * 1024 + (ob ^ (((ob >> 9) & 1) << 5)); }
DI void stage_rc(int b, int& R, int& C) { const int st = b / 1024, sb = b % 1024, swz = sb ^ (((sb >> 9) & 1) << 5); R = (st >> 1) * 16 + swz / 64; C = (st & 1) * 32 + (swz % 64) / 2; }
struct Unit { int pm, pn; };
struct Gemm { const bf16_t* A; const bf16_t* Bt; int M, N, K; };
struct StaticOrder {
    int nM, nN, nwg, G, c;
    DI void init(int M, int N, int G_, int c_) { nM = M / BM; nN = N / BM; nwg = nM * nN; G = G_; c = c_; }
    DI bool next(int i, Unit& u) const {
        const long L = (long)i * G + c; if (L >= nwg) return false;
        int wgid = (int)L; { const int q = nwg / NXCD, r = nwg % NXCD, xcd = wgid % NXCD, off = wgid / NXCD; wgid = (xcd < r ? xcd * (q + 1) : r * (q + 1) + (xcd - r) * q) + off; }
        const int nig = WGM * nN, gid = wgid / nig, fm = gid * WGM, gsz = (nM - fm) < WGM ? (nM - fm) : WGM;
        u.pm = fm + ((wgid % nig) % gsz); u.pn = (wgid % nig) / gsz; return true;
    }
};
template <class Epi>
DI void gemm_phase(LAS unsigned char* lds, const Gemm g, const StaticOrder& S, const Epi& E) {
    const int tid = tidx(), wid = __builtin_amdgcn_readfirstlane(tid >> 6), lane = tid & 63, wr = wid >> 2, wc = wid & 3, fr = lane & 15, fq = lane >> 4;
    const int K = g.K, nt = K / BK;
    unsigned voffA[2];
#pragma unroll
    for (int i = 0; i < 2; ++i) { int R, C; stage_rc(tid * 16 + i * 8192, R, C); voffA[i] = (unsigned)(R * K + C) * 2u; }
    const size_t kstep = (size_t)(BK * 2);
    const size_t hstep = (size_t)HALF * K * 2;
    const size_t tstep = 2 * hstep;
    const unsigned ldsw = (unsigned)wid * 1024u;
    const int aoff = lds_byte(wr * 64 + fr, fq * 8), boff = lds_byte(wc * 32 + fr, fq * 8);
#define PG8_SA(b, h) (((b) * 2 + (h)) * HTB)
#define PG8_SB(b, h) ((4 + (b) * 2 + (h)) * HTB)
#define PG8_STAGE(bufoff, gbase, voff) do { _Pragma("unroll") for (int _i = 0; _i < 2; ++_i) \
        __builtin_amdgcn_global_load_lds((const unsigned*)((const char*)(gbase) + (voff)[_i]), (LAS unsigned*)(lds + (bufoff) + ldsw + _i * 8192), 16, 0, 0); } while (0)
#define PG8_LDA(dst, b, h) do { _Pragma("unroll") for (int m = 0; m < 4; ++m) _Pragma("unroll") for (int k = 0; k < 2; ++k) dst[m][k] = *(const LAS bf16x8*)(lds + PG8_SA(b, h) + aoff + m * 2048 + k * 1024); } while (0)
#define PG8_LDB(dst, b, h) do { _Pragma("unroll") for (int n = 0; n < 2; ++n) _Pragma("unroll") for (int k = 0; k < 2; ++k) dst[n][k] = *(const LAS bf16x8*)(lds + PG8_SB(b, h) + boff + n * 2048 + k * 1024); } while (0)
#define PG8_MMA(ai, bj, At, Bt) do { __builtin_amdgcn_s_setprio(1); _Pragma("unroll") for (int m = 0; m < 4; ++m) _Pragma("unroll") for (int n = 0; n < 2; ++n) _Pragma("unroll") for (int k = 0; k < 2; ++k) \
        acc[ai][bj][m][n] = __builtin_amdgcn_mfma_f32_16x16x32_bf16(Bt[n][k], At[m][k], acc[ai][bj][m][n], 0, 0, 0); __builtin_amdgcn_s_setprio(0); } while (0)
#define PG8_WAIT_V(n) asm volatile("s_waitcnt vmcnt(" #n ")" ::: "memory")
#define PG8_WAIT_L(n) asm volatile("s_waitcnt lgkmcnt(" #n ")" ::: "memory")
#define PG8_BAR __builtin_amdgcn_s_barrier()
#define PG8_SCHED __builtin_amdgcn_sched_barrier(0)
    Unit cur, nxt; int ui = 0;
    if (!S.next(0, cur)) return;
    f32x4 acc[2][2][4][2];
#pragma unroll
    for (int a = 0; a < 2; ++a)
#pragma unroll
        for (int b = 0; b < 2; ++b)
#pragma unroll
            for (int m = 0; m < 4; ++m)
#pragma unroll
                for (int n = 0; n < 2; ++n) acc[a][b][m][n] = (f32x4){0.f, 0.f, 0.f, 0.f};
    bf16x8 At[4][2], B0[2][2], B1[2][2];
    const char* cA = (const char*)g.A + (size_t)cur.pm * tstep; const char* cB = (const char*)g.Bt + (size_t)cur.pn * tstep;
    PG8_STAGE(PG8_SB(0, 0), cB, voffA); PG8_STAGE(PG8_SA(0, 0), cA, voffA); PG8_STAGE(PG8_SB(0, 1), cB + hstep, voffA); PG8_STAGE(PG8_SA(0, 1), cA + hstep, voffA);
    if (wr == 1) PG8_BAR;
    PG8_WAIT_V(4); PG8_BAR;
    PG8_STAGE(PG8_SB(1, 0), cB + kstep, voffA); PG8_STAGE(PG8_SA(1, 0), cA + kstep, voffA); PG8_STAGE(PG8_SB(1, 1), cB + hstep + kstep, voffA);
    PG8_WAIT_V(6); PG8_BAR;
    for (;;) {
        const bool has_next = S.next(ui + 1, nxt);
        const char* nA = has_next ? (const char*)g.A + (size_t)nxt.pm * tstep : cA; const char* nB = has_next ? (const char*)g.Bt + (size_t)nxt.pn * tstep : cB;
#pragma nounroll
        for (int t = 0; t < nt; t += 2) {
            const bool last = (t == nt - 2);
            const char* a1 = cA + (size_t)(t + 1) * kstep;
            const char* a2 = last ? nA : cA + (size_t)(t + 2) * kstep; const char* b2 = last ? nB : cB + (size_t)(t + 2) * kstep;
            const char* a3 = a2 + kstep; const char* b3 = b2 + kstep;
            PG8_LDB(B0, 0, 0); PG8_SCHED; PG8_LDA(At, 0, 0); PG8_STAGE(PG8_SA(1, 1), a1 + hstep, voffA);
            PG8_WAIT_L(8); PG8_BAR; PG8_WAIT_L(0); PG8_MMA(0, 0, At, B0); PG8_BAR; PG8_SCHED;
            PG8_LDB(B1, 0, 1); PG8_STAGE(PG8_SB(0, 0), b2, voffA);
            PG8_BAR; PG8_WAIT_L(0); PG8_MMA(0, 1, At, B1); PG8_BAR;
            PG8_LDA(At, 0, 1); PG8_STAGE(PG8_SA(0, 0), a2, voffA);
            PG8_BAR; PG8_WAIT_L(0); PG8_MMA(1, 0, At, B0); PG8_BAR; PG8_SCHED;
            PG8_STAGE(PG8_SB(0, 1), b2 + hstep, voffA);
            PG8_WAIT_V(6); PG8_BAR; PG8_MMA(1, 1, At, B1); PG8_BAR;
            PG8_LDB(B0, 1, 0); PG8_SCHED; PG8_LDA(At, 1, 0); PG8_STAGE(PG8_SA(0, 1), a2 + hstep, voffA);
            PG8_WAIT_L(8); PG8_BAR; PG8_WAIT_L(0); PG8_MMA(0, 0, At, B0); PG8_BAR; PG8_SCHED;
            PG8_LDB(B1, 1, 1); PG8_STAGE(PG8_SB(1, 0), b3, voffA);
            PG8_BAR; PG8_WAIT_L(0); PG8_MMA(0, 1, At, B1); PG8_BAR;
            PG8_LDA(At, 1, 1); PG8_STAGE(PG8_SA(1, 0), a3, voffA);
            PG8_BAR; PG8_WAIT_L(0); PG8_MMA(1, 0, At, B0); PG8_BAR; PG8_SCHED;
            PG8_STAGE(PG8_SB(1, 1), b3 + hstep, voffA);
            PG8_WAIT_V(6); PG8_BAR; PG8_MMA(1, 1, At, B1); PG8_BAR;
        }
        E(acc, cur, wr, wc, fr, fq);
#if PROBE == 12
        if (Epi::ID != 3) E(acc, cur, wr, wc, fr, fq);
#endif
        if (!has_next) break;
#pragma unroll
        for (int a = 0; a < 2; ++a)
#pragma unroll
            for (int b = 0; b < 2; ++b)
#pragma unroll
                for (int m = 0; m < 4; ++m)
#pragma unroll
                    for (int n = 0; n < 2; ++n) acc[a][b][m][n] = (f32x4){0.f, 0.f, 0.f, 0.f};
        cur = nxt; cA = nA; cB = nB; ++ui;
    }
    PG8_WAIT_V(0);
    if (wr == 0) PG8_BAR;
    PG8_BAR;
#undef PG8_SA
#undef PG8_SB
#undef PG8_STAGE
#undef PG8_LDA
#undef PG8_LDB
#undef PG8_MMA
#undef PG8_WAIT_V
#undef PG8_WAIT_L
#undef PG8_BAR
#undef PG8_SCHED
}
}
using pg8::Unit;

template <class F> DI void epi_foreach(const f32x4 (&acc)[2][2][4][2], const Unit& u, const F& f) {
    const int tl = tidx();
    const int fr = tl & 15, fq = (tl >> 4) & 3, wc = (tl >> 6) & 3, wr = tl >> 8;
    const int row0 = u.pm * 256 + wr * 64 + fr, col0 = u.pn * 256 + wc * 64 + 8 * fq;
#pragma unroll
    for (int ai = 0; ai < 2; ++ai)
#pragma unroll
        for (int m = 0; m < 4; ++m)
#pragma unroll
            for (int bj = 0; bj < 2; ++bj) f(row0 + ai * 128 + m * 16, col0 + bj * 32, acc[ai][bj][m][0], acc[ai][bj][m][1]);
}
DI void st_bf16x4(bf16_t* p, f32x4 v) { u32x2 w; w.x = cvt_pk_bf16(v[0], v[1]); w.y = cvt_pk_bf16(v[2], v[3]); *(u32x2*)p = w; }
DI void st_bf16x8(bf16_t* p, f32x4 v0, f32x4 v1) { u32x4 w; w.x = cvt_pk_bf16(v0[0], v0[1]); w.y = cvt_pk_bf16(v0[2], v0[3]); w.z = cvt_pk_bf16(v1[0], v1[1]); w.w = cvt_pk_bf16(v1[2], v1[3]); *(u32x4*)p = w; }

struct EpiIn { static constexpr int ID = 0;
    bf16_t* z1a; bf16_t* z2; bf16_t* z1b; float* gates; const float* bg;
    DI void operator()(const f32x4 (&acc)[2][2][4][2], const Unit& u, int, int, int, int) const {
        epi_foreach(acc, u, [&](int r, int c, f32x4 v0, f32x4 v1) {
            if (c < ZC_VML) st_bf16x8(z1a + (size_t)r * 928 + c, v0, v1);
            else if (c < ZC_GATES) st_bf16x8(z2 + (size_t)r * 1024 + (c - ZC_VML), v0, v1);
            else if (c < ZC_QG) { const f32x4 b0 = *(const f32x4*)(bg + (c - ZC_GATES)), b1 = *(const f32x4*)(bg + (c - ZC_GATES) + 4);
                                  *(f32x4*)(gates + (size_t)r * 16 + (c - ZC_GATES)) = v0 + b0; *(f32x4*)(gates + (size_t)r * 16 + (c - ZC_GATES) + 4) = v1 + b1; }
            else if (c < ZC_END) st_bf16x8(z1b + (size_t)r * 512 + (c - ZC_QG), v0, v1);
        });
    }
};
struct EpiA2 { static constexpr int ID = 1;
    bf16_t* qmla; bf16_t* kvmla; const f32x2* rope;
    DI void operator()(const f32x4 (&acc)[2][2][4][2], const Unit& u, int, int, int, int) const {
        epi_foreach(acc, u, [&](int r, int c, f32x4 v0, f32x4 v1) {
            if (c < 384) {
                if (r < NT) {
                    const int d = c % 96;
                    if (d >= 64 && r >= NCTX) {
                        const int pos = (r - NCTX) & 2047; const int half = (d - 64) >> 4, i0 = ((d - 64) & 15) >> 1;
                        const f32x2* t = rope + (half ? (pos & 63) : (pos >> 6)) * 8 + i0;
                        const f32x2 t0 = t[0], t1 = t[1], t2 = t[2], t3 = t[3];
                        v0 = (f32x4){v0[0] * t0.x - v0[1] * t0.y, v0[0] * t0.y + v0[1] * t0.x, v0[2] * t1.x - v0[3] * t1.y, v0[2] * t1.y + v0[3] * t1.x};
                        v1 = (f32x4){v1[0] * t2.x - v1[1] * t2.y, v1[0] * t2.y + v1[1] * t2.x, v1[2] * t3.x - v1[3] * t3.y, v1[2] * t3.y + v1[3] * t3.x};
                    }
                    st_bf16x8(qmla + (size_t)r * 384 + c, v0, v1);
                }
            } else if (c < 896) st_bf16x8(kvmla + (size_t)r * 512 + (c - 384), v0, v1);
        });
    }
};
struct EpiA3 { static constexpr int ID = 2;
    bf16_t* qk3;
    DI void operator()(const f32x4 (&acc)[2][2][4][2], const Unit& u, int, int, int, int) const {
        epi_foreach(acc, u, [&](int r, int c, f32x4 v0, f32x4 v1) {
            if (c >= 512) { v0 = v0 * 0.08838834764831845f; v1 = v1 * 0.08838834764831845f; }
            st_bf16x8(qk3 + (size_t)r * 1024 + c, v0, v1);
        });
    }
};
struct EpiRes { static constexpr int ID = 3;
    const float* src0; const float* src1; float* dst; const float* gate;
    DI void operator()(const f32x4 (&acc)[2][2][4][2], const Unit& u, int, int, int, int) const {
        const int tl = tidx(); const int fr = tl & 15, fq = (tl >> 4) & 3, wc = (tl >> 6) & 3, wr = tl >> 8;
        const int row0 = u.pm * 256 + wr * 64 + fr, col0 = u.pn * 256 + wc * 64 + 8 * fq;
        const float* gp = gate + (size_t)mod_index(u.pm * 256) * 6144 + col0;
        f32x4 g[2][2];
#pragma unroll
        for (int bj = 0; bj < 2; ++bj)
#pragma unroll
            for (int n = 0; n < 2; ++n) g[bj][n] = *(const f32x4*)(gp + bj * 32 + n * 4);
        const float* sbase = (u.pm * 256 < NCTX) ? src0 + (size_t)row0 * 1024 : src1 + (size_t)(row0 - NCTX) * 1024;
        float* dbase = dst + (size_t)row0 * 1024;
#pragma unroll
        for (int ai = 0; ai < 2; ++ai)
#pragma unroll
            for (int mp = 0; mp < 2; ++mp) {
                f32x4 x[2][2][2];
#pragma unroll
                for (int mm = 0; mm < 2; ++mm)
#pragma unroll
                    for (int bj = 0; bj < 2; ++bj)
#pragma unroll
                        for (int n = 0; n < 2; ++n) x[mm][bj][n] = *(const f32x4*)(sbase + (size_t)(ai * 128 + (2 * mp + mm) * 16) * 1024 + col0 + bj * 32 + n * 4);
#pragma unroll
                for (int mm = 0; mm < 2; ++mm)
#pragma unroll
                    for (int bj = 0; bj < 2; ++bj)
#pragma unroll
                        for (int n = 0; n < 2; ++n) *(f32x4*)(dbase + (size_t)(ai * 128 + (2 * mp + mm) * 16) * 1024 + col0 + bj * 32 + n * 4) = x[mm][bj][n] + g[bj][n] * acc[ai][bj][2 * mp + mm][n];
            }
    }
};
struct EpiUp { static constexpr int ID = 5;
    bf16_t* H; float* GB; float* AB; const float* wc; const float* bc;
    DI void operator()(const f32x4 (&acc)[2][2][4][2], const Unit& u, int, int, int, int) const {
        const int tl = tidx(); const int fr = tl & 15, fq = (tl >> 4) & 3, wcol = (tl >> 6) & 3, wr = tl >> 8;
        const int j = u.pn * 128 + wcol * 32 + 8 * fq;
        f32x4 w0[2], w1[2], w2[2], bb[2];
#pragma unroll
        for (int n = 0; n < 2; ++n) { w0[n] = *(const f32x4*)(wc + j + 4 * n); w1[n] = *(const f32x4*)(wc + 2816 + j + 4 * n); w2[n] = *(const f32x4*)(wc + 2 * 2816 + j + 4 * n); bb[n] = *(const f32x4*)(bc + j + 4 * n); }
#pragma unroll
        for (int ai = 0; ai < 2; ++ai)
#pragma unroll
            for (int m = 0; m < 4; ++m) {
                const int r = u.pm * 256 + ai * 128 + wr * 64 + m * 16 + fr;
                const int rr = (m * 16 + fr);
                f32x4 o[2];
#pragma unroll
                for (int n = 0; n < 2; ++n) {
                    const f32x4 a4 = acc[ai][0][m][n], g4 = acc[ai][1][m][n];
#pragma unroll
                    for (int i = 0; i < 4; ++i) {
                        float pm = 0.f, nm = 0.f;
                        if (m > 0) pm = row_prev(acc[ai][1][m > 0 ? m - 1 : 0][n][i]);
                        if (m < 3) nm = row_next(acc[ai][1][m < 3 ? m + 1 : 3][n][i]);
                        const float gp = row_shr1(pm, g4[i]), gn = row_shl1(nm, g4[i]);
                        o[n][i] = siluf(bb[n][i] + w0[n][i] * gp + w1[n][i] * g4[i] + w2[n][i] * gn) * a4[i];
                    }
                }
                if (rr != 0 && rr != 63) st_bf16x8(H + (size_t)r * 2816 + j, o[0], o[1]);
                if (rr <= 1 || rr >= 62) {
                    const int slot = rr <= 1 ? rr : rr - 60;
                    float* gb = GB + ((size_t)(r >> 6) * 4 + slot) * 2816 + j; *(f32x4*)gb = acc[ai][1][m][0]; *(f32x4*)(gb + 4) = acc[ai][1][m][1];
                    if (rr == 0 || rr == 63) { float* ab = AB + ((size_t)(r >> 6) * 2 + (rr == 63 ? 1 : 0)) * 2816 + j; *(f32x4*)ab = acc[ai][0][m][0]; *(f32x4*)(ab + 4) = acc[ai][0][m][1]; }
                }
            }
    }
};
template <class Epi> DI void run_gemm(unsigned char* smem, const bf16_t* A, const bf16_t* Bt, int M, int N, int K, const Epi& E) {
    pg8::Gemm g; g.A = A; g.Bt = Bt; g.M = M; g.N = N; g.K = K;
    pg8::StaticOrder S; S.init(M, N, (int)gdim(), (int)bidx());
    pg8::gemm_phase<Epi>((LAS unsigned char*)smem, g, S, E);
    __syncthreads();
}
DI int gemm_first_idle(int M, int N) { const int rem = ((M / 256) * (N / 256)) % gdim(); return rem == 0 ? gdim() : rem; }
DI int up_srccol(int n) { const int hb = n >> 8, r = n & 255; return r < 128 ? hb * 128 + r : 2816 + hb * 128 + (r - 128); }
DI int perm_row(int n) { const int rho = n & 31, nn = rho >> 4, i = rho & 15; return (n & ~31) + 8 * (i >> 2) + 4 * nn + (i & 3); }
DI int perm_row2(int n) { const int p = perm_row(n); const int s = p & 255, bj = s >> 7, wc = (s >> 5) & 3; return (p & ~255) + 64 * wc + 32 * bj + (s & 31); }
DI void convert_tiled(unsigned char* smem, const float* src, int ld, int K, int Nd, int nsrc, int kind, bf16_t* dst, int& item, const int nblk) {
    float* tile = (float*)smem;
    const int tk = K / 64, tn = Nd / 64, ntiles = tk * tn, tid = tidx();
    for (; item < ntiles; item += 2 * nblk) {
        float v[2][8];
#pragma unroll
        for (int tt = 0; tt < 2; ++tt) { const int it = item + tt * nblk; if (it < ntiles) {
            const int k0 = (it % tk) * 64, n0 = (it / tk) * 64;
            const int nn = tid & 63; const int n = kind >= 3 ? perm_row(n0 + nn + (kind == 4 ? 2816 : 0)) : perm_row2(n0 + nn); const int sc = kind >= 3 ? up_srccol(n) : (n < nsrc ? n : -1);
#pragma unroll
            for (int i = 0; i < 8; ++i) { const int kk = (tid >> 6) + 8 * i; v[tt][i] = sc >= 0 ? src[(size_t)(k0 + kk) * ld + sc] : 0.f; } } }
#pragma unroll
        for (int tt = 0; tt < 2; ++tt) { const int nn = tid & 63;
#pragma unroll
            for (int i = 0; i < 8; ++i) { const int kk = (tid >> 6) + 8 * i; tile[tt * 4160 + kk * 65 + nn] = v[tt][i]; } }
        __syncthreads();
#pragma unroll
        for (int tt = 0; tt < 2; ++tt) { const int it = item + tt * nblk; if (it < ntiles) {
            const int k0 = (it % tk) * 64, n0 = (it / tk) * 64;
#pragma unroll
            for (int i = 0; i < 8; ++i) { const int n2 = (tid >> 6) + 8 * i; const int k2 = tid & 63; dst[(size_t)(n0 + n2) * K + k0 + k2] = f2bf(tile[tt * 4160 + k2 * 65 + n2]); } } }
        __syncthreads();
    }
    item -= ntiles; if (item >= nblk) item -= nblk;
}
DI void convert_weights_b(unsigned char* smem, const PA& p, int l, int part, int bi, int nb) {
    unsigned char* W = p.ws() + WS_W;
    int item = bi;
    const float* wup = p.in(I_WUP) + (size_t)l * 1024 * 5632;
    if (part == 0) {
        convert_tiled(smem, wup, 5632, 1024, 2816, 5632, 3, (bf16_t*)(W + W_UP), item, nb);
        convert_tiled(smem, p.in(I_WDN) + (size_t)l * 2816 * 1024, 1024, 2816, 1024, 1024, 0, (bf16_t*)(W + W_DN), item, nb);
    } else {
        convert_tiled(smem, wup, 5632, 1024, 2816, 5632, 4, (bf16_t*)(W + W_UP) + (size_t)2816 * 1024, item, nb);
    }
}
DI void convert_weights(unsigned char* smem, const PA& p, int l, int bi, int nb) {
    unsigned char* W = p.ws() + WS_W;
    int item = bi;
    convert_tiled(smem, p.in(I_WIN) + (size_t)l * 1024 * 2480, 2480, 1024, 2560, 2480, 0, (bf16_t*)(W + W_IN), item, nb);
    convert_tiled(smem, p.in(I_WOUT) + (size_t)l * 1024 * 1024, 1024, 1024, 1024, 1024, 0, (bf16_t*)(W + W_OUT), item, nb);
    const float* wuq = p.in(I_WUQ) + (size_t)l * 256 * 384; const float* wukv = p.in(I_WUKV) + (size_t)l * 128 * 512;
    const float* wq = p.in(I_WMLQ) + (size_t)l * 4 * 128 * 128; const float* wk = p.in(I_WMLK) + (size_t)l * 4 * 128 * 128;
    bf16_t* b2 = (bf16_t*)(W + W_B2); bf16_t* b3 = (bf16_t*)(W + W_B3);
    const int gt = bi * 512 + tidx(), gs = nb * 512;
    for (int e = gt; e < 1024 * 384; e += gs) {
        const int n = perm_row2(e / 384), k = e % 384; float v = 0.f;
        if (n < 384) { if (k < 256) { const int hh = n / 96, r = n % 96; int sc = n;
                if (r >= 64) { const int q = r - 64, half = q >> 4, pp = q & 15; const int nat = (pp & 1) ? 8 + (pp >> 1) : (pp >> 1); sc = hh * 96 + 64 + half * 16 + nat; }
                v = wuq[(size_t)k * 384 + sc]; } }
        else if (n < 896) { if (k >= 256) v = wukv[(size_t)(k - 256) * 512 + (n - 384)]; }
        b2[e] = f2bf(v);
    }
    for (int e = gt; e < 1024 * 512; e += gs) {
        const int n = perm_row2(e / 512), k = e % 512; const int hh = (n & 511) >> 7, ee = n & 127; float v = 0.f;
        if ((k >> 7) == hh) v = (n < 512 ? wq : wk)[(size_t)hh * 16384 + (size_t)(k & 127) * 128 + ee];
        b3[e] = f2bf(v);
    }
}

DI void phase_mod(unsigned char* smem, const PA& p) {
    float* sv = (float*)smem;
    float* red = sv + 9 * 1024;
    const int tid = tidx(), wid = tid >> 6, lane = tid & 63;
    for (int e = tid; e < 9 * 1024; e += 512) { const int v = e >> 10, k = e & 1023; const float x = v == 0 ? p.in(I_CCTX)[k] : p.in(I_C)[(size_t)(v - 1) * 1024 + k]; sv[e] = siluf(x); }
    __syncthreads();
    float* mod = (float*)(p.ws() + WS_MOD);
    for (int item = bidx(); item < 192; item += gdim()) {
        const int l = item / 96, col0 = (item % 96) * 64;
        const float* w = p.in(I_WADA) + (size_t)l * 1024 * 6144 + col0 + lane;
        float acc[9];
#pragma unroll
        for (int v = 0; v < 9; ++v) acc[v] = 0.f;
        const int kb = wid * 128;
#pragma unroll 4
        for (int k4 = 0; k4 < 32; ++k4) {
            float wv[4];
#pragma unroll
            for (int j = 0; j < 4; ++j) wv[j] = w[(size_t)(kb + 4 * k4 + j) * 6144];
#pragma unroll
            for (int v = 0; v < 9; ++v) { const f32x4 s4 = *(const f32x4*)(sv + v * 1024 + kb + 4 * k4); acc[v] += s4[0] * wv[0] + s4[1] * wv[1] + s4[2] * wv[2] + s4[3] * wv[3]; } }
#pragma unroll
        for (int v = 0; v < 9; ++v) red[(wid * 9 + v) * 64 + lane] = acc[v];
        __syncthreads();
        for (int e = tid; e < 576; e += 512) { const int v = e >> 6, cc = e & 63; float s = p.in(I_BADA)[(size_t)l * 6144 + col0 + cc];
#pragma unroll
            for (int w8 = 0; w8 < 8; ++w8) s += red[(w8 * 9 + v) * 64 + cc];
            mod[((size_t)l * 9 + v) * 6144 + col0 + cc] = s; }
        __syncthreads();
    }
}

DI void phase_norm(const PA& p, int l, int which, bf16_t* Y) {
    const int lane = tidx() & 63, gw = bidx() * 8 + (tidx() >> 6), nw = gdim() * 8;
    const float* g = p.in(which == 1 ? I_GN1 : I_GN2) + (size_t)l * 1024;
    const float* mod = (const float*)(p.ws() + WS_MOD) + (size_t)l * 9 * 6144;
    const float* X = p.out(); const float* xp = p.in(I_XP); const float* xs = p.in(I_XS);
    const bool from_in = (l == 0 && which == 1);
    constexpr int R = 3;
    for (int row0 = gw; row0 < NT; row0 += nw * R) {
        f32x4 x[R][4]; float ss[R];
#pragma unroll
        for (int r = 0; r < R; ++r) { const int row = row0 + r * nw; ss[r] = 0.f;
            if (row < NT) { const float* src = from_in ? (row < NCTX ? xp + (size_t)row * 1024 : xs + (size_t)(row - NCTX) * 1024) : X + (size_t)row * 1024;
#pragma unroll
                for (int i = 0; i < 4; ++i) x[r][i] = *(const f32x4*)(src + lane * 4 + 256 * i); } }
#pragma unroll
        for (int r = 0; r < R; ++r) { const int row = row0 + r * nw; if (row >= NT) continue;
#pragma unroll
            for (int i = 0; i < 4; ++i) ss[r] += x[r][i][0] * x[r][i][0] + x[r][i][1] * x[r][i][1] + x[r][i][2] * x[r][i][2] + x[r][i][3] * x[r][i][3];
            ss[r] = wave_sum(ss[r]); const float rstd = rsqrtf(ss[r] * (1.f / 1024.f) + EPS);
            const float* mv = mod + (size_t)mod_index(row) * 6144 + (which == 1 ? 0 : 3072);
#pragma unroll
            for (int i = 0; i < 4; ++i) { const int c = lane * 4 + 256 * i; const f32x4 gg = *(const f32x4*)(g + c), sh = *(const f32x4*)(mv + c), sc = *(const f32x4*)(mv + 1024 + c);
                const f32x4 y = (x[r][i] * rstd) * gg * (sc + 1.f) + sh; st_bf16x4(Y + (size_t)row * 1024 + c, y); } }
    }
}
DI void phase_final(const PA& p) {
    const int lane = tidx() & 63, gw = bidx() * 8 + (tidx() >> 6), nw = gdim() * 8;
    const float* g = p.in(I_GFIN); float* X = p.out();
    constexpr int R = 3;
    for (int row0 = gw; row0 < NT; row0 += nw * R) {
        f32x4 x[R][4];
#pragma unroll
        for (int r = 0; r < R; ++r) { const int row = row0 + r * nw;
            if (row < NT) {
#pragma unroll
                for (int i = 0; i < 4; ++i) x[r][i] = *(const f32x4*)(X + (size_t)row * 1024 + lane * 4 + 256 * i); } }
#pragma unroll
        for (int r = 0; r < R; ++r) { const int row = row0 + r * nw; if (row >= NT) continue; float ss = 0.f;
#pragma unroll
            for (int i = 0; i < 4; ++i) ss += x[r][i][0] * x[r][i][0] + x[r][i][1] * x[r][i][1] + x[r][i][2] * x[r][i][2] + x[r][i][3] * x[r][i][3];
            ss = wave_sum(ss); const float rstd = rsqrtf(ss * (1.f / 1024.f) + EPS);
#pragma unroll
            for (int i = 0; i < 4; ++i) { const int c = lane * 4 + 256 * i; *(f32x4*)(X + (size_t)row * 1024 + c) = (x[r][i] * rstd) * *(const f32x4*)(g + c); } }
    }
}

DI float rope_inv(int i, float per) { return exp2f(-(float)i * per); }
DI void phase_prep(const PA& p, int l) {
    const int lane = tidx() & 63, gw = bidx() * 8 + (tidx() >> 6), nw = gdim() * 8;
    unsigned char* ws = p.ws();
    const bf16_t* Z1a = (const bf16_t*)(ws + WS_RB); bf16_t* Z1b = (bf16_t*)(ws + WS_RE);
    bf16_t* A2 = (bf16_t*)(ws + WS_RA); bf16_t* A3 = A2 + (size_t)NA2 * 384;
    bf16_t* KR = (bf16_t*)(ws + WS_RF + F_KROPE); bf16_t* CKG = (bf16_t*)(ws + WS_RF + F_CKG); bf16_t* CVG = (bf16_t*)(ws + WS_RF + F_CVG);
    const float* gq = p.in(I_GMQ) + (size_t)l * 256; const float* gkv = p.in(I_GMKV) + (size_t)l * 128;
    const float* wc = p.in(I_WMLC) + (size_t)l * 3 * 512; const float* bc = p.in(I_BMLC) + (size_t)l * 512;
    const float* ggq = p.in(I_GGQ) + (size_t)l * 64; const float* ggk = p.in(I_GGK) + (size_t)l * 64;
    const f32x2* ropem = (const f32x2*)(ws + WS_ROPE); const f32x2* ropeg = ropem + 512;
    for (int row = NT + gw; row < NA2; row += nw) {
        const int b = (row - NT) >> 8, j = (row - NT) & 255; const size_t cr = ((size_t)(b * 2 + l) * 256 + j);
        { unsigned zz = 0u; asm volatile("" : "+v"(zz)); u32x2 z; z.x = zz; z.y = zz; *(u32x2*)(A2 + (size_t)row * 384 + lane * 4) = z; }
        { const float* s_ = p.in(I_CCKV) + cr * 128 + lane * 2; *(unsigned*)(A2 + (size_t)row * 384 + 256 + lane * 2) = cvt_pk_bf16(s_[0], s_[1]); }
        if (lane < 16) { const int half = lane >> 3, i = lane & 7; const float* s_ = p.in(I_CKROPE) + cr * 32 + half * 16; *(unsigned*)(KR + (size_t)row * 32 + half * 16 + 2 * i) = cvt_pk_bf16(s_[i], s_[i + 8]); }
        { const float* s_ = p.in(I_CGK) + cr * 128 + lane * 2; *(unsigned*)(CKG + ((size_t)(b * 256 + j)) * 128 + lane * 2) = cvt_pk_bf16(s_[0], s_[1]); }
        { const float* s_ = p.in(I_CGV) + cr * 128 + lane * 2; *(unsigned*)(CVG + ((size_t)(b * 256 + j)) * 128 + lane * 2) = cvt_pk_bf16(s_[0], s_[1]); }
    }
    { const int j0 = lane * 8; float wv[3][8], bv[8];
#pragma unroll
      for (int j = 0; j < 8; ++j) { bv[j] = bc[j0 + j]; wv[0][j] = wc[j0 + j]; wv[1][j] = wc[512 + j0 + j]; wv[2][j] = wc[1024 + j0 + j]; }
      constexpr int R = 3;
      for (int row0 = gw; row0 < NT; row0 += nw * R) {
          u32x4 uv[R][3];
#pragma unroll
          for (int r = 0; r < R; ++r) { const int t = row0 + r * nw; if (t < NT) { int pos, T; seq_pos(t, pos, T);
#pragma unroll
              for (int d = 0; d < 3; ++d) { const int pp = pos + d - 1; uv[r][d] = (pp >= 0 && pp < T) ? *(const u32x4*)(Z1a + (size_t)(t + d - 1) * 928 + ZC_U + j0) : (u32x4){0u, 0u, 0u, 0u}; } } }
#pragma unroll
          for (int r = 0; r < R; ++r) { const int t = row0 + r * nw; if (t >= NT) continue;
              unsigned o[4];
#pragma unroll
              for (int k = 0; k < 4; ++k) { const unsigned* u0 = (const unsigned*)&uv[r][0]; const unsigned* u1 = (const unsigned*)&uv[r][1]; const unsigned* u2 = (const unsigned*)&uv[r][2];
                  const float c0 = bv[2 * k] + wv[0][2 * k] * bflo(u0[k]) + wv[1][2 * k] * bflo(u1[k]) + wv[2][2 * k] * bflo(u2[k]);
                  const float c1 = bv[2 * k + 1] + wv[0][2 * k + 1] * bfhi(u0[k]) + wv[1][2 * k + 1] * bfhi(u1[k]) + wv[2][2 * k + 1] * bfhi(u2[k]);
                  o[k] = cvt_pk_bf16(siluf(c0), siluf(c1)); }
              *(u32x4*)(A3 + (size_t)t * 512 + j0) = (u32x4){o[0], o[1], o[2], o[3]}; }
      } }
    const f32x4 gq4 = *(const f32x4*)(gq + lane * 4); const float gkv0 = gkv[lane * 2], gkv1 = gkv[lane * 2 + 1];
    const int li = lane & 15, d0 = li * 4;
    const f32x4 ggq4 = *(const f32x4*)(ggq + d0), ggk4 = *(const f32x4*)(ggk + d0);
    constexpr int R2 = 2;
    for (int row0 = gw; row0 < NT; row0 += nw * R2) {
        u32x2 wq[R2], wz[R2][2], wvg[R2]; unsigned wkv[R2], wkr[R2];
#pragma unroll
        for (int r = 0; r < R2; ++r) { const int t = row0 + r * nw; if (t < NT) {
            const bf16_t* z = Z1a + (size_t)t * 928; const bf16_t* zb = Z1b + (size_t)t * 512;
            wq[r] = *(const u32x2*)(z + lane * 4); wkv[r] = *(const unsigned*)(z + 256 + lane * 2);
            wkr[r] = lane < 16 ? ((unsigned)z[384 + (lane >> 3) * 16 + (lane & 7)] | ((unsigned)z[384 + (lane >> 3) * 16 + (lane & 7) + 8] << 16)) : 0u;
            wz[r][0] = *(const u32x2*)(zb + lane * 4); wz[r][1] = lane < 32 ? *(const u32x2*)(zb + 256 + lane * 4) : (u32x2){0u, 0u};
            wvg[r] = (t < NCTX && lane >= 32) ? *(const u32x2*)(zb + 384 + (lane - 32) * 4) : (u32x2){0u, 0u}; } }
#pragma unroll
        for (int r = 0; r < R2; ++r) { const int t = row0 + r * nw; if (t >= NT) continue;
            int pos, T; seq_pos(t, pos, T); const bool ctx = t < NCTX; const int b = ctx ? (t >> 8) : 0;
            const size_t orow = ((size_t)(b * 2 + l) * 256 + pos);
            { float v[4] = {bflo(wq[r].x), bfhi(wq[r].x), bflo(wq[r].y), bfhi(wq[r].y)};
              float ss = v[0] * v[0] + v[1] * v[1] + v[2] * v[2] + v[3] * v[3]; ss = wave_sum(ss); const float rs = rsqrtf(ss * (1.f / 256.f) + EPS);
              st_bf16x4(A2 + (size_t)t * 384 + lane * 4, (f32x4){v[0] * rs * gq4[0], v[1] * rs * gq4[1], v[2] * rs * gq4[2], v[3] * rs * gq4[3]}); }
            { float v0 = bflo(wkv[r]), v1 = bfhi(wkv[r]);
              float ss = wave_sum(v0 * v0 + v1 * v1); const float rs = rsqrtf(ss * (1.f / 128.f) + EPS);
              v0 = v0 * rs * gkv0; v1 = v1 * rs * gkv1;
              *(unsigned*)(A2 + (size_t)t * 384 + 256 + lane * 2) = cvt_pk_bf16(v0, v1);
              if (ctx) { float* o = p.out() + O_CKV + orow * 128 + lane * 2; *(f32x2*)o = (f32x2){v0, v1}; } }
            if (lane < 16) { const int half = lane >> 3, i = lane & 7; float x1 = bflo(wkr[r]), x2 = bfhi(wkr[r]);
              if (ctx) { float* o = p.out() + O_KROPE + orow * 32 + half * 16; o[i] = x1; o[i + 8] = x2; }
              else { const f32x2 tt = ropem[(half ? (pos & 63) : (pos >> 6)) * 8 + i]; const float c = tt.x, sn = tt.y; const float o1 = x1 * c - x2 * sn, o2 = x1 * sn + x2 * c; x1 = o1; x2 = o2; }
              *(unsigned*)(KR + (size_t)t * 32 + half * 16 + 2 * i) = cvt_pk_bf16(x1, x2); }
            bf16_t* zb = Z1b + (size_t)t * 512;
#pragma unroll
            for (int part = 0; part < 2; ++part) {
                const bool act = part == 0 || lane < 32;
                const int off = part * 256 + lane * 4;
                const u32x2 w = wz[r][part];
                float v[4] = {bflo(w.x), bfhi(w.x), bflo(w.y), bfhi(w.y)};
                float ss = v[0] * v[0] + v[1] * v[1] + v[2] * v[2] + v[3] * v[3];
                ss += __shfl_xor(ss, 1); ss += __shfl_xor(ss, 2); ss += __shfl_xor(ss, 4); ss += __shfl_xor(ss, 8);
                const float rs = rsqrtf(ss * (1.f / 64.f) + EPS); const f32x4 gg = part == 0 ? ggq4 : ggk4;
#pragma unroll
                for (int j = 0; j < 4; ++j) v[j] = v[j] * rs * gg[j];
                if (part == 1 && ctx && act) { float* o = p.out() + O_GK + orow * 128 + lane * 4; *(f32x4*)o = (f32x4){v[0], v[1], v[2], v[3]}; }
                if (!ctx) {
                    float pr[4];
#pragma unroll
                    for (int j = 0; j < 4; ++j) pr[j] = __shfl_xor(v[j], 4);
                    const bool isx2 = (li & 4) != 0; const int pq = (li & 8) ? (pos & 63) : (pos >> 6);
#pragma unroll
                    for (int j = 0; j < 4; ++j) { const int i = (d0 + j) & 15; const f32x2 tt = ropeg[pq * 16 + i]; const float c = tt.x, sn = tt.y;
                        v[j] = isx2 ? (pr[j] * sn + v[j] * c) : (v[j] * c - pr[j] * sn); } }
                if (act) st_bf16x4(zb + off, (f32x4){v[0], v[1], v[2], v[3]});
            }
            if (ctx && lane >= 32) { const int c4 = (lane - 32) * 4; *(f32x4*)(p.out() + O_GV + orow * 128 + c4) = (f32x4){bflo(wvg[r].x), bfhi(wvg[r].x), bflo(wvg[r].y), bfhi(wvg[r].y)}; }
        }
    }
}

struct AttnArgs {
    const bf16_t* q; int qs;
    const bf16_t* ka0; const bf16_t* ka1; int kas0, kas1; const bf16_t* kb0; const bf16_t* kb1; int kbs0, kbs1; const bf16_t* v0; const bf16_t* v1; int vs0, vs1;
    int nt1, nt;
    bf16_t* o; int os; float sc;
};
template <int DK> DI void attn_item(unsigned char* smem, const AttnArgs& a) {
    constexpr int KST = DK + 8, CPR = DK / 8, NKS = DK / 32, KBYTES = 64 * KST * 2, BUFB = KBYTES + 64 * 72 * 2;
    const int tid = tidx(), wid = tid >> 6, lane = tid & 63, c = lane & 15, g = lane >> 4;
    bf16x8 qf[2][NKS];
#pragma unroll
    for (int qg = 0; qg < 2; ++qg)
#pragma unroll
        for (int ks = 0; ks < NKS; ++ks) qf[qg][ks] = *(const bf16x8*)(a.q + (size_t)(wid * 32 + qg * 16 + c) * a.qs + ks * 32 + g * 8);
    f32x4 O[4][2]; float mrun[2], lsum[2];
#pragma unroll
    for (int qg = 0; qg < 2; ++qg) { mrun[qg] = -INFINITY; lsum[qg] = 0.f;
#pragma unroll
        for (int db = 0; db < 4; ++db) O[db][qg] = (f32x4){0.f, 0.f, 0.f, 0.f}; }
    bf16x8 kreg[2], vreg[4];
    const int key0 = tid / CPR, cc0 = tid % CPR, key1 = (tid + 512) / CPR, cc1 = (tid + 512) % CPR;
    const bool has1 = DK > 64 && (tid + 512) < 64 * CPR; const bool isv = tid >= 256 && tid < 384; const int vt = tid - 256, sg = vt & 15, e0 = vt >> 4;
    const int vpos = 32 * (sg >> 3) + 8 * (sg & 3) + 4 * ((sg >> 2) & 1);
    const bf16_t* kp0; const bf16_t* kp1; const bf16_t* vp; int kst0, kst1, vst;
    auto rebase = [&](int seg) {
        const bf16_t* ka = seg ? a.ka1 : a.ka0; const bf16_t* kb = seg ? a.kb1 : a.kb0; const int kas = seg ? a.kas1 : a.kas0, kbs = seg ? a.kbs1 : a.kbs0;
        kp0 = cc0 < 8 ? ka + (size_t)key0 * kas + cc0 * 8 : kb + (size_t)key0 * kbs + (cc0 - 8) * 8; kst0 = 64 * (cc0 < 8 ? kas : kbs);
        kp1 = cc1 < 8 ? ka + (size_t)key1 * kas + cc1 * 8 : kb + (size_t)key1 * kbs + (cc1 - 8) * 8; kst1 = 64 * (cc1 < 8 ? kas : kbs);
        vst = seg ? a.vs1 : a.vs0; vp = (seg ? a.v1 : a.v0) + (size_t)(4 * sg) * vst + e0 * 8;
    };
    auto load_tile = [&]() {
        kreg[0] = *(const bf16x8*)kp0; kp0 += kst0;
        if (has1) { kreg[1] = *(const bf16x8*)kp1; kp1 += kst1; }
        if (isv) {
#pragma unroll
            for (int r = 0; r < 4; ++r) vreg[r] = *(const bf16x8*)(vp + (size_t)r * vst);
            vp += (size_t)64 * vst; }
    };
    auto write_tile = [&](int buf) {
        LAS bf16_t* Ks = (LAS bf16_t*)(smem + buf * BUFB); LAS bf16_t* VT = (LAS bf16_t*)(smem + buf * BUFB + KBYTES);
        *(LAS bf16x8*)(Ks + key0 * KST + cc0 * 8) = kreg[0];
        if (has1) *(LAS bf16x8*)(Ks + key1 * KST + cc1 * 8) = kreg[1];
        if (isv) {
#pragma unroll
            for (int j = 0; j < 8; ++j) { u32x2 w; w.x = ((unsigned)(unsigned short)vreg[0][j]) | (((unsigned)(unsigned short)vreg[1][j]) << 16); w.y = ((unsigned)(unsigned short)vreg[2][j]) | (((unsigned)(unsigned short)vreg[3][j]) << 16);
                *(LAS u32x2*)(VT + (e0 * 8 + j) * 72 + vpos) = w; } }
    };
    rebase(0); load_tile(); write_tile(0);
    if (a.nt > 1) { if (a.nt1 == 1) rebase(1); load_tile(); }
    __syncthreads();
    for (int kt = 0; kt < a.nt; ++kt) {
        if (kt + 1 < a.nt) write_tile((kt + 1) & 1);
        if (kt + 2 < a.nt) { if (kt + 2 == a.nt1) rebase(1); load_tile(); }
        const LAS bf16_t* Ks = (const LAS bf16_t*)(smem + (kt & 1) * BUFB); const LAS bf16_t* VT = (const LAS bf16_t*)(smem + (kt & 1) * BUFB + KBYTES);
        bf16x8 kf[NKS][4];
#pragma unroll
        for (int ks = 0; ks < NKS; ++ks)
#pragma unroll
            for (int sb = 0; sb < 4; ++sb) kf[ks][sb] = *(const LAS bf16x8*)(Ks + (16 * sb + c) * KST + ks * 32 + g * 8);
        f32x4 S[2][4];
#pragma unroll
        for (int qg = 0; qg < 2; ++qg)
#pragma unroll
            for (int sb = 0; sb < 4; ++sb) { f32x4 acc = (f32x4){0.f, 0.f, 0.f, 0.f};
#pragma unroll
                for (int ks = 0; ks < NKS; ++ks) acc = __builtin_amdgcn_mfma_f32_16x16x32_bf16(kf[ks][sb], qf[qg][ks], acc, 0, 0, 0);
                S[qg][sb] = acc; }
        bf16x8 vf[2][4];
#pragma unroll
        for (int u = 0; u < 2; ++u)
#pragma unroll
            for (int db = 0; db < 4; ++db) vf[u][db] = *(const LAS bf16x8*)(VT + (16 * db + c) * 72 + 32 * u + 8 * g);
#pragma unroll
        for (int qg = 0; qg < 2; ++qg) {
            float mx = max3f(max3f(S[qg][0][0], S[qg][0][1], S[qg][0][2]), max3f(S[qg][0][3], S[qg][1][0], S[qg][1][1]), max3f(S[qg][1][2], S[qg][1][3], S[qg][2][0]));
            mx = max3f(mx, max3f(S[qg][2][1], S[qg][2][2], S[qg][2][3]), max3f(S[qg][3][0], S[qg][3][1], S[qg][3][2]));
            mx = fmaxf(mx, S[qg][3][3]);
            if (__builtin_amdgcn_ballot_w64((mx - mrun[qg]) * a.sc > 8.f) != 0ull) {
                mx = fmaxf(mx, __shfl_xor(mx, 16)); mx = fmaxf(mx, __shfl_xor(mx, 32));
                const float mn = fmaxf(mrun[qg], mx); const float alpha = exp2raw((mrun[qg] - mn) * a.sc); mrun[qg] = mn;
                lsum[qg] *= alpha;
#pragma unroll
                for (int db = 0; db < 4; ++db) O[db][qg] = O[db][qg] * alpha;
            }
            const float mb = mrun[qg] * a.sc; float ps0 = 0.f, ps1 = 0.f;
            bf16x8 P[2];
#pragma unroll
            for (int sb = 0; sb < 4; ++sb) {
                const float p0 = exp2raw(__builtin_fmaf(S[qg][sb][0], a.sc, -mb)), p1 = exp2raw(__builtin_fmaf(S[qg][sb][1], a.sc, -mb));
                const float p2 = exp2raw(__builtin_fmaf(S[qg][sb][2], a.sc, -mb)), p3 = exp2raw(__builtin_fmaf(S[qg][sb][3], a.sc, -mb));
                S[qg][sb] = (f32x4){p0, p1, p2, p3}; ps0 += p0 + p2; ps1 += p1 + p3; }
            lsum[qg] += ps0 + ps1;
#pragma unroll
            for (int u = 0; u < 2; ++u) { u32x4 w; w.x = cvt_pk_bf16(S[qg][2 * u][0], S[qg][2 * u][1]); w.y = cvt_pk_bf16(S[qg][2 * u][2], S[qg][2 * u][3]);
                w.z = cvt_pk_bf16(S[qg][2 * u + 1][0], S[qg][2 * u + 1][1]); w.w = cvt_pk_bf16(S[qg][2 * u + 1][2], S[qg][2 * u + 1][3]); P[u] = __builtin_bit_cast(bf16x8, w); }
#pragma unroll
            for (int u = 0; u < 2; ++u)
#pragma unroll
                for (int db = 0; db < 4; ++db) O[db][qg] = __builtin_amdgcn_mfma_f32_16x16x32_bf16(vf[u][db], P[u], O[db][qg], 0, 0, 0);
        }
        __syncthreads();
    }
#pragma unroll
    for (int qg = 0; qg < 2; ++qg) {
        float l = lsum[qg]; l += __shfl_xor(l, 16); l += __shfl_xor(l, 32); const float inv = 1.f / l;
#pragma unroll
        for (int db = 0; db < 4; ++db) st_bf16x4(a.o + (size_t)(wid * 32 + qg * 16 + c) * a.os + 16 * db + 4 * g, O[db][qg] * inv);
    }
}

template <int SPLIT> DI void mlstm_item(unsigned char* smem, const PA& p, int l, int seq_is_lat, int b, int h, int dir, int eh) {
    constexpr int ST = 136, NEB = SPLIT ? 4 : 8, NDB = SPLIT ? 4 : 8, EROWS = 16 * NEB;
    LAS bf16_t* Ks = (LAS bf16_t*)smem; LAS bf16_t* KwT = Ks + 128 * ST; LAS bf16_t* VT = KwT + 128 * ST; LAS bf16_t* CT = VT + EROWS * ST;
    LAS float* fv = (LAS float*)(smem + (256 + 2 * EROWS) * ST * 2);
    LAS float* s_bc = fv; LAS float* s_a = fv + 128; LAS float* s_M = fv + 256; LAS float* s_n = fv + 384;
    const int tid = tidx(), wid = tid >> 6, lane = tid & 63, c = lane & 15, g = lane >> 4;
    const int we = SPLIT ? (wid & 3) : wid, wd = SPLIT ? (wid >> 2) : 0;
    unsigned char* ws = p.ws();
    const bf16_t* QK3 = (const bf16_t*)(ws + WS_RB); const bf16_t* Z2 = (const bf16_t*)(ws + WS_RC); const float* gates = (const float*)(ws + WS_RF + F_GATES);
    bf16_t* CAT = (bf16_t*)(ws + WS_RA); bf16_t* HB = (bf16_t*)(ws + WS_W + W_UP);
    const int T = seq_is_lat ? 2048 : 256, nc = T / 128; const int tok0 = seq_is_lat ? NCTX + b * 2048 : b * 256;
    const int e_off = eh * 64;
    f32x4 Cacc[NDB]; float m_prev;
    const size_t sidx = (((size_t)b * 2 + l) * 2 + dir) * 4 + h;
    if (seq_is_lat) {
        const float* c0 = p.in(I_SC) + sidx * 16384;
#pragma unroll
        for (int db = 0; db < NDB; ++db) Cacc[db] = *(const f32x4*)(c0 + (size_t)((NDB * wd + db) * 16 + c) * 128 + e_off + 16 * we + 4 * g);
        if (tid < 128) s_n[tid] = p.in(I_SN)[sidx * 128 + tid];
        m_prev = p.in(I_SM)[sidx];
    } else {
#pragma unroll
        for (int db = 0; db < NDB; ++db) Cacc[db] = (f32x4){0.f, 0.f, 0.f, 0.f};
        if (tid < 128) s_n[tid] = 0.f;
        m_prev = 0.f;
    }
#pragma unroll
    for (int db = 0; db < NDB; ++db)
#pragma unroll
        for (int i = 0; i < 4; ++i) CT[(16 * we + 4 * g + i) * ST + (NDB * wd + db) * 16 + c] = f2bf(Cacc[db][i]);
    bf16x8 kpre[4], vpre[4]; float gpre[4];
    const int sgq = tid & 31, e0q = tid >> 5;
    auto rowof = [&](int ck, int pidx) { const int P = ck * 128 + pidx; return tok0 + (dir == 0 ? P : T - 1 - P); };
    auto load_pre = [&](int ck) {
#pragma unroll
        for (int i = 0; i < 4; ++i) { const int q = tid + 512 * i, s_ = q >> 4, cc = q & 15; kpre[i] = *(const bf16x8*)(QK3 + (size_t)rowof(ck, s_) * 1024 + 512 + h * 128 + cc * 8); }
        if (tid < 64 * NEB) {
#pragma unroll
            for (int r = 0; r < 4; ++r) vpre[r] = *(const bf16x8*)(Z2 + (size_t)rowof(ck, 4 * sgq + r) * 1024 + h * 128 + e_off + e0q * 8); }
        if (wid == 0) {
#pragma unroll
            for (int e = 0; e < 2; ++e) { const float* gr = gates + (size_t)rowof(ck, 2 * lane + e) * 16 + dir * 8 + h; gpre[2 * e] = gr[0]; gpre[2 * e + 1] = gr[4]; } }
    };
    load_pre(0);
    for (int ck = 0; ck < nc; ++ck) {
        if (wid == 0) {
            float li2[2], lf2[2];
#pragma unroll
            for (int e = 0; e < 2; ++e) { li2[e] = gpre[2 * e]; const float f = gpre[2 * e + 1]; lf2[e] = fminf(f, 0.f) - log1pf(__expf(-fabsf(f))); }
            float s1 = lf2[0] + lf2[1], inc = s1;
#pragma unroll
            for (int o = 1; o < 64; o <<= 1) { const float t2 = __shfl_up(inc, o); if (lane >= o) inc += t2; }
            const float ex = inc - s1; const float bc0 = ex + lf2[0], bc1 = ex + s1;
            const float a0 = li2[0] - bc0, a1 = li2[1] - bc1;
            float pm = fmaxf(a0, a1);
#pragma unroll
            for (int o = 1; o < 64; o <<= 1) { const float t2 = __shfl_up(pm, o); if (lane >= o) pm = fmaxf(pm, t2); }
            float pex = __shfl_up(pm, 1); if (lane == 0) pex = -INFINITY;
            s_bc[2 * lane] = bc0; s_bc[2 * lane + 1] = bc1; s_a[2 * lane] = a0; s_a[2 * lane + 1] = a1;
            s_M[2 * lane] = fmaxf(m_prev, fmaxf(pex, a0)); s_M[2 * lane + 1] = fmaxf(m_prev, pm);
        }
#pragma unroll
        for (int i = 0; i < 4; ++i) { const int q = tid + 512 * i, s_ = q >> 4, cc = q & 15; *(LAS bf16x8*)(Ks + s_ * ST + cc * 8) = kpre[i]; }
        const int trow = rowof(ck, 16 * wid + c);
        bf16x8 qf[4];
#pragma unroll
        for (int ks = 0; ks < 4; ++ks) qf[ks] = *(const bf16x8*)(QK3 + (size_t)trow * 1024 + h * 128 + ks * 32 + g * 8);
        __syncthreads();
        const float Mlast = s_M[127]; const float blast = s_bc[127];
        { float wk[4];
#pragma unroll
          for (int r = 0; r < 4; ++r) wk[r] = __expf(s_a[4 * sgq + r] - Mlast);
          bf16x8 kr[4];
#pragma unroll
          for (int r = 0; r < 4; ++r) kr[r] = *(const LAS bf16x8*)(Ks + (4 * sgq + r) * ST + e0q * 8);
#pragma unroll
          for (int j = 0; j < 8; ++j) {
              u32x2 k2; k2.x = cvt_pk_bf16(bf2f((bf16_t)kr[0][j]) * wk[0], bf2f((bf16_t)kr[1][j]) * wk[1]); k2.y = cvt_pk_bf16(bf2f((bf16_t)kr[2][j]) * wk[2], bf2f((bf16_t)kr[3][j]) * wk[3]);
              *(LAS u32x2*)(KwT + (e0q * 8 + j) * ST + 4 * sgq) = k2; }
          if (tid < 64 * NEB) {
#pragma unroll
              for (int j = 0; j < 8; ++j) {
                  u32x2 w; w.x = ((unsigned)(unsigned short)vpre[0][j]) | (((unsigned)(unsigned short)vpre[1][j]) << 16); w.y = ((unsigned)(unsigned short)vpre[2][j]) | (((unsigned)(unsigned short)vpre[3][j]) << 16);
                  *(LAS u32x2*)(VT + (e0q * 8 + j) * ST + 4 * sgq) = w; } } }
        __syncthreads();
        if (ck + 1 < nc) load_pre(ck + 1);
        const int t = 16 * wid + c; const float Mt = s_M[t]; const float inter = __expf(m_prev - Mt);
        bf16x8 Pk[4]; float rowsum = 0.f;
#pragma unroll
        for (int u = 0; u < 4; ++u) {
            f32x4 S0 = (f32x4){0.f, 0.f, 0.f, 0.f}, S1 = S0;
#pragma unroll
            for (int ks = 0; ks < 4; ++ks) {
                const int k0 = 32 * u + 8 * (c >> 2) + (c & 3);
                const bf16x8 a0 = *(const LAS bf16x8*)(Ks + k0 * ST + ks * 32 + g * 8); const bf16x8 a1 = *(const LAS bf16x8*)(Ks + (k0 + 4) * ST + ks * 32 + g * 8);
                S0 = __builtin_amdgcn_mfma_f32_16x16x32_bf16(a0, qf[ks], S0, 0, 0, 0); S1 = __builtin_amdgcn_mfma_f32_16x16x32_bf16(a1, qf[ks], S1, 0, 0, 0);
            }
            float w8[8];
#pragma unroll
            for (int i = 0; i < 4; ++i) { const int s0 = 32 * u + 8 * g + i, s1 = s0 + 4;
                w8[i] = s0 <= t ? S0[i] * __expf(s_a[s0] - Mt) : 0.f; w8[4 + i] = s1 <= t ? S1[i] * __expf(s_a[s1] - Mt) : 0.f; }
#pragma unroll
            for (int i = 0; i < 8; ++i) rowsum += w8[i];
            u32x4 w; w.x = cvt_pk_bf16(w8[0], w8[1]); w.y = cvt_pk_bf16(w8[2], w8[3]); w.z = cvt_pk_bf16(w8[4], w8[5]); w.w = cvt_pk_bf16(w8[6], w8[7]); Pk[u] = __builtin_bit_cast(bf16x8, w);
        }
        rowsum += __shfl_xor(rowsum, 16); rowsum += __shfl_xor(rowsum, 32);
        float qn = 0.f;
#pragma unroll
        for (int ks = 0; ks < 4; ++ks)
#pragma unroll
            for (int j = 0; j < 8; ++j) qn += bf2f((bf16_t)qf[ks][j]) * s_n[ks * 32 + g * 8 + j];
        qn += __shfl_xor(qn, 16); qn += __shfl_xor(qn, 32);
        const float den = rowsum + inter * qn; const float dnm = fmaxf(fabsf(den), __expf(-(s_bc[t] + Mt))); const float rden = 1.f / dnm;
        bf16_t* orow = dir == 0 ? CAT + (size_t)trow * 1024 + 256 + h * 128 + e_off : HB + (size_t)trow * 512 + h * 128 + e_off;
#pragma unroll
        for (int eb = 0; eb < NEB; ++eb) { f32x4 n4 = (f32x4){0.f, 0.f, 0.f, 0.f};
#pragma unroll
            for (int ks = 0; ks < 4; ++ks) { const bf16x8 af = *(const LAS bf16x8*)(CT + (16 * eb + c) * ST + ks * 32 + g * 8); n4 = __builtin_amdgcn_mfma_f32_16x16x32_bf16(af, qf[ks], n4, 0, 0, 0); }
            n4 = n4 * inter;
#pragma unroll
            for (int u = 0; u < 4; ++u) { const bf16x8 af = *(const LAS bf16x8*)(VT + (16 * eb + c) * ST + 32 * u + 8 * g); n4 = __builtin_amdgcn_mfma_f32_16x16x32_bf16(af, Pk[u], n4, 0, 0, 0); }
            st_bf16x4(orow + 16 * eb + 4 * g, n4 * rden); }
        const float decay = __expf(m_prev - Mlast);
        { bf16x8 af[4];
#pragma unroll
          for (int u = 0; u < 4; ++u) af[u] = *(const LAS bf16x8*)(VT + (16 * we + c) * ST + 32 * u + 8 * g);
#pragma unroll
          for (int db = 0; db < NDB; ++db) { f32x4 cc = Cacc[db] * decay;
#pragma unroll
              for (int u = 0; u < 4; ++u) { const bf16x8 bfr = *(const LAS bf16x8*)(KwT + (16 * (NDB * wd + db) + c) * ST + 32 * u + 8 * g); cc = __builtin_amdgcn_mfma_f32_16x16x32_bf16(af[u], bfr, cc, 0, 0, 0); }
              Cacc[db] = cc; } }
        float nnew = 0.f;
        if (tid < 128) { float sacc = 0.f;
#pragma unroll 4
            for (int s8 = 0; s8 < 16; ++s8) { const bf16x8 kk = *(const LAS bf16x8*)(KwT + tid * ST + s8 * 8);
#pragma unroll
                for (int j = 0; j < 8; ++j) sacc += bf2f((bf16_t)kk[j]); }
            nnew = decay * s_n[tid] + sacc; }
        m_prev = blast + Mlast;
        __syncthreads();
        if (tid < 128) s_n[tid] = nnew;
#pragma unroll
        for (int db = 0; db < NDB; ++db)
#pragma unroll
            for (int i = 0; i < 4; ++i) CT[(16 * we + 4 * g + i) * ST + (NDB * wd + db) * 16 + c] = f2bf(Cacc[db][i]);
    }
    __syncthreads();
    if (!seq_is_lat) {
        float* co = p.out() + O_C + sidx * 16384;
#pragma unroll
        for (int db = 0; db < NDB; ++db) *(f32x4*)(co + (size_t)((NDB * wd + db) * 16 + c) * 128 + e_off + 16 * we + 4 * g) = Cacc[db];
        if (eh == 0) { if (tid < 128) p.out()[O_N + sidx * 128 + tid] = s_n[tid];
                       if (tid == 0) p.out()[O_M + sidx] = m_prev; }
    }
    __syncthreads();
}

DI void phase_hn(const PA& p, int l) {
    const int lane = tidx() & 63, gw = bidx() * 8 + (tidx() >> 6), nw = gdim() * 8;
    unsigned char* ws = p.ws();
    bf16_t* CAT = (bf16_t*)(ws + WS_RA); const bf16_t* HB = (const bf16_t*)(ws + WS_W + W_UP); const bf16_t* Z2 = (const bf16_t*)(ws + WS_RC);
    const float* gout = p.in(I_GMLOUT) + (size_t)l * 512 + lane * 8;
    f32x4 g0 = *(const f32x4*)gout, g1 = *(const f32x4*)(gout + 4);
    constexpr int R = 4;
    for (int row0 = gw; row0 < NT; row0 += nw * R) {
        u32x4 a[R], b[R], o[R];
#pragma unroll
        for (int r = 0; r < R; ++r) { const int row = row0 + r * nw; if (row < NT) {
            a[r] = *(const u32x4*)(CAT + (size_t)row * 1024 + 256 + lane * 8); b[r] = *(const u32x4*)(HB + (size_t)row * 512 + lane * 8); o[r] = *(const u32x4*)(Z2 + (size_t)row * 1024 + 512 + lane * 8); } }
#pragma unroll
        for (int r = 0; r < R; ++r) { const int row = row0 + r * nw; if (row >= NT) continue;
            float v[8] = {bflo(a[r].x) + bflo(b[r].x), bfhi(a[r].x) + bfhi(b[r].x), bflo(a[r].y) + bflo(b[r].y), bfhi(a[r].y) + bfhi(b[r].y), bflo(a[r].z) + bflo(b[r].z), bfhi(a[r].z) + bfhi(b[r].z), bflo(a[r].w) + bflo(b[r].w), bfhi(a[r].w) + bfhi(b[r].w)};
            float ss = 0.f;
#pragma unroll
            for (int j = 0; j < 8; ++j) ss += v[j] * v[j];
            ss += __shfl_xor(ss, 1); ss += __shfl_xor(ss, 2); ss += __shfl_xor(ss, 4); ss += __shfl_xor(ss, 8);
            const float rs = rsqrtf(ss * (1.f / 128.f) + EPS);
            const float og[8] = {bflo(o[r].x), bfhi(o[r].x), bflo(o[r].y), bfhi(o[r].y), bflo(o[r].z), bfhi(o[r].z), bflo(o[r].w), bfhi(o[r].w)};
            const float gg[8] = {g0[0], g0[1], g0[2], g0[3], g1[0], g1[1], g1[2], g1[3]};
#pragma unroll
            for (int j = 0; j < 8; ++j) v[j] = v[j] * rs * gg[j] * sigmoidf(og[j]);
            u32x4 w; w.x = cvt_pk_bf16(v[0], v[1]); w.y = cvt_pk_bf16(v[2], v[3]); w.z = cvt_pk_bf16(v[4], v[5]); w.w = cvt_pk_bf16(v[6], v[7]);
            *(u32x4*)(CAT + (size_t)row * 1024 + 256 + lane * 8) = w; }
    }
}

DI void phase_mixers(unsigned char* smem, const PA& p, int l, int rep) {
    unsigned char* ws = p.ws();
    unsigned* ctr = (unsigned*)(ws + WS_CTRL) + 64 * (1 + l + 2 * rep);
    LAS int* s_item = (LAS int*)(smem + LDS_BYTES - 64);
    const bf16_t* QMLA = (const bf16_t*)(ws + WS_RF + F_QMLA); const bf16_t* KV = (const bf16_t*)(ws + WS_RF + F_KVMLA); const bf16_t* KR = (const bf16_t*)(ws + WS_RF + F_KROPE);
    const bf16_t* Z1b = (const bf16_t*)(ws + WS_RE); const bf16_t* CKG = (const bf16_t*)(ws + WS_RF + F_CKG); const bf16_t* CVG = (const bf16_t*)(ws + WS_RF + F_CVG);
    bf16_t* CAT = (bf16_t*)(ws + WS_RA);
    for (;;) {
        __syncthreads();
        if (tidx() == 0) *s_item = (int)atomicAdd(ctr, 1u);
        __syncthreads();
        const int it = *s_item;
        if (it >= 1088) break;
        if (it < 64) { mlstm_item<0>(smem, p, l, 1, it >> 3, (it >> 1) & 3, it & 1, 0); continue; }
        if (it >= 576 && it < 832) { const int j = it - 576; mlstm_item<0>(smem, p, l, 0, j >> 3, (j >> 1) & 3, j & 1, 0); continue; }
        int lat, kind, b, h, qb;
        if (it < 576) { const int j = it - 64; lat = 1; kind = j >> 8; const int r = j & 255; b = r >> 5; h = (r >> 3) & 3; qb = r & 7; }
        else { const int j = it - 832; lat = 0; kind = j >> 7; const int r = j & 127; b = r >> 2; h = r & 3; qb = 0; }
        const int tok0 = lat ? NCTX + b * 2048 : b * 256; const int q0 = tok0 + qb * 256;
        AttnArgs a;
        a.nt1 = lat ? 32 : 4; a.nt = lat ? 36 : 4;
        if (kind == 0) {
            a.q = QMLA + (size_t)q0 * 384 + h * 96; a.qs = 384;
            a.ka0 = KV + (size_t)tok0 * 512 + h * 128; a.kas0 = 512; a.kb0 = KR + (size_t)tok0 * 32; a.kbs0 = 32; a.v0 = KV + (size_t)tok0 * 512 + h * 128 + 64; a.vs0 = 512;
            const size_t cr = (size_t)NT + b * 256;
            a.ka1 = KV + cr * 512 + h * 128; a.kas1 = 512; a.kb1 = KR + cr * 32; a.kbs1 = 32; a.v1 = KV + cr * 512 + h * 128 + 64; a.vs1 = 512;
            a.o = CAT + (size_t)q0 * 1024 + h * 64; a.os = 1024; a.sc = 0.10206207261596577f * LOG2E;
            attn_item<96>(smem, a);
#if PROBE == 6
            attn_item<96>(smem, a);
#endif
        } else {
            const int kvh = h >> 1;
            a.q = Z1b + (size_t)q0 * 512 + h * 64; a.qs = 512;
            a.ka0 = Z1b + (size_t)tok0 * 512 + 256 + kvh * 64; a.kas0 = 512; a.kb0 = a.ka0; a.kbs0 = 512; a.v0 = Z1b + (size_t)tok0 * 512 + 384 + kvh * 64; a.vs0 = 512;
            a.ka1 = CKG + (size_t)b * 256 * 128 + kvh * 64; a.kas1 = 128; a.kb1 = a.ka1; a.kbs1 = 128; a.v1 = CVG + (size_t)b * 256 * 128 + kvh * 64; a.vs1 = 128;
            a.o = CAT + (size_t)q0 * 1024 + 768 + h * 64; a.os = 1024; a.sc = 0.125f * LOG2E;
            attn_item<64>(smem, a);
#if PROBE == 6
            attn_item<64>(smem, a);
#endif
        }
    }
}

DI void phase_ffix(const PA& p, int l, const float* GB, const float* AB, bf16_t* H) {
    const float* wc = p.in(I_WFC) + (size_t)l * 3 * 2816; const float* bc = p.in(I_BFC) + (size_t)l * 2816;
    const int total = 384 * 2 * 704;
    for (int e = bidx() * 512 + tidx(); e < total; e += gdim() * 512) {
        const int j = (e % 704) * 4, gr = e / 704, G = gr >> 1, hi = gr & 1;
        const int r = G * 64 + (hi ? 63 : 0); int pos, T; seq_pos(r, pos, T);
        const f32x4 zero = (f32x4){0.f, 0.f, 0.f, 0.f};
        f32x4 gp, gc, gn;
        if (!hi) { gp = pos > 0 ? *(const f32x4*)(GB + ((size_t)(G - 1) * 4 + 3) * 2816 + j) : zero; gc = *(const f32x4*)(GB + ((size_t)G * 4 + 0) * 2816 + j); gn = *(const f32x4*)(GB + ((size_t)G * 4 + 1) * 2816 + j); }
        else     { gp = *(const f32x4*)(GB + ((size_t)G * 4 + 2) * 2816 + j); gc = *(const f32x4*)(GB + ((size_t)G * 4 + 3) * 2816 + j); gn = pos < T - 1 ? *(const f32x4*)(GB + ((size_t)(G + 1) * 4 + 0) * 2816 + j) : zero; }
        const f32x4 a4 = *(const f32x4*)(AB + ((size_t)G * 2 + hi) * 2816 + j);
        const f32x4 w0 = *(const f32x4*)(wc + j), w1 = *(const f32x4*)(wc + 2816 + j), w2 = *(const f32x4*)(wc + 2 * 2816 + j), bb = *(const f32x4*)(bc + j);
        f32x4 o;
#pragma unroll
        for (int i = 0; i < 4; ++i) o[i] = siluf(bb[i] + w0[i] * gp[i] + w1[i] * gc[i] + w2[i] * gn[i]) * a4[i];
        st_bf16x4(H + (size_t)r * 2816 + j, o);
    }
}

constexpr int NPHASE = 24, PPL = 11;
DI int probe_reps(int ph) {
    if (ph == 0 || ph == NPHASE - 1) return 1;
    const int q = (ph - 1) % PPL;
    if (PROBE == 1) return q == 4 ? 2 : 1;
    if (PROBE == 2) return (q == 1 || q == 3 || q == 8) ? 2 : 1;
    if (PROBE == 4) return (q == 0 || q == 7 || q == 9) ? 2 : 1;
    if (PROBE == 8) return q == 1 ? 2 : 1;
    if (PROBE == 9) return q == 8 ? 2 : 1;
    if (PROBE == 10) return q == 3 ? 2 : 1;
    if (PROBE == 11) return q == 2 ? 1 : (q == 5 ? 2 : 1);
    return 1;
}
DI void run_phase(unsigned char* smem, const PA& p, int ph, int rep) {
    unsigned char* ws = p.ws();
    if (ph == 0) {
        if (bidx() == 0) for (int i = tidx(); i < 5120; i += 512) ((unsigned*)(ws + WS_CTRL))[i] = 0u;
        if (bidx() == gdim() - 1) {
            f32x2* tm = (f32x2*)(ws + WS_ROPE); f32x2* tg = tm + 512;
            for (int e = tidx(); e < 1536; e += 512) { const bool m = e < 512; const int ee = m ? e : e - 512; const int pos = m ? ee >> 3 : ee >> 4, i = m ? ee & 7 : ee & 15;
                float sn, cs; sincosf((float)pos * exp2f(-(float)i * (13.287712379549449f / (m ? 8.f : 16.f))), &sn, &cs); (m ? tm : tg)[ee] = (f32x2){cs, sn}; }
        }
        phase_mod(smem, p);
        convert_weights(smem, p, 0, bidx(), gdim());
        return;
    }
    if (ph == NPHASE - 1) { phase_final(p); return; }
    int l = (ph - 1) / PPL, q = (ph - 1) % PPL;
    asm volatile("" : "+s"(l), "+s"(q));
    unsigned char* W = ws + WS_W;
    const float* mod = (const float*)(ws + WS_MOD);
    bf16_t* RA = (bf16_t*)(ws + WS_RA); bf16_t* RB = (bf16_t*)(ws + WS_RB); bf16_t* RC = (bf16_t*)(ws + WS_RC); bf16_t* RE = (bf16_t*)(ws + WS_RE);
    bf16_t* H = RB; float* GB = (float*)(ws + WS_RB + (size_t)NT * 2816 * 2); float* AB = GB + (size_t)384 * 4 * 2816;
    switch (q) {
    case 0: phase_norm(p, l, 1, RA); break;
    case 1: { EpiIn e; e.z1a = RB; e.z2 = RC; e.z1b = RE; e.gates = (float*)(ws + WS_RF + F_GATES); e.bg = p.in(I_BGATES) + (size_t)l * 16;
              run_gemm(smem, RA, (const bf16_t*)(W + W_IN), NT, 2560, 1024, e); } break;
    case 2:
#ifndef NO_PREP
        phase_prep(p, l);
#endif
        break;
    case 3: { EpiA2 e; e.qmla = (bf16_t*)(ws + WS_RF + F_QMLA); e.kvmla = (bf16_t*)(ws + WS_RF + F_KVMLA); e.rope = (const f32x2*)(ws + WS_ROPE);
              run_gemm(smem, RA, (const bf16_t*)(W + W_B2), NA2, 1024, 384, e); }
            { EpiA3 e; e.qk3 = RB;
              run_gemm(smem, RA + (size_t)NA2 * 384, (const bf16_t*)(W + W_B3), NT, 1024, 512, e); } break;
    case 4:
#ifndef NO_MIX
        phase_mixers(smem, p, l, rep);
#endif
        break;
    case 5: phase_hn(p, l); break;
    case 6: { EpiRes e; e.src0 = l == 0 ? p.in(I_XP) : p.out(); e.src1 = l == 0 ? p.in(I_XS) : p.out() + (size_t)NCTX * 1024; e.dst = p.out(); e.gate = mod + (size_t)l * 9 * 6144 + 2048;
              run_gemm(smem, RA, (const bf16_t*)(W + W_OUT), NT, 1024, 1024, e);
              { const int fi = gemm_first_idle(NT, 1024); if (bidx() >= fi) convert_weights_b(smem, p, l, 0, bidx() - fi, gdim() - fi); else if (fi == gdim()) convert_weights_b(smem, p, l, 0, bidx(), gdim()); } } break;
    case 7: convert_weights_b(smem, p, l, 1, bidx(), gdim()); phase_norm(p, l, 2, RA); break;
    case 8: { EpiUp e; e.H = H; e.GB = GB; e.AB = AB; e.wc = p.in(I_WFC) + (size_t)l * 3 * 2816; e.bc = p.in(I_BFC) + (size_t)l * 2816;
              run_gemm(smem, RA, (const bf16_t*)(W + W_UP), NT, 5632, 1024, e);
              if (l == 0) { const int fi = gemm_first_idle(NT, 5632); if (bidx() >= fi) convert_weights(smem, p, 1, bidx() - fi, gdim() - fi); else if (fi == gdim()) convert_weights(smem, p, 1, bidx(), gdim()); } } break;
    case 9: phase_ffix(p, l, GB, AB, H); break;
    default: { EpiRes e; e.src0 = p.out(); e.src1 = p.out() + (size_t)NCTX * 1024; e.dst = p.out(); e.gate = mod + (size_t)l * 9 * 6144 + 5120;
               run_gemm(smem, H, (const bf16_t*)(W + W_DN), NT, 1024, 2816, e); } break;
    }
}
__global__ void __launch_bounds__(512, 2) fwd_megakernel(Params p) {
    extern __shared__ __attribute__((aligned(16))) unsigned char smem[];
    cg::grid_group grid = cg::this_grid();
    typedef const __attribute__((address_space(4))) Params* CParams;
    volatile LAS unsigned* st = (volatile LAS unsigned*)(smem + LDS_BYTES - 32);
    XcdBarrier xb; xb.bar = nullptr; xb.x = 0; xb.st = st;
    int redo = 0;
    for (int ph = 0; ph < NPHASE; ++ph) {
#if PROBE == 11
        if (ph > 0 && ph < NPHASE - 1) { const int q = (ph - 1) % PPL; if (q == 3) { if (!redo) { redo = 1; ph -= 2; } else redo = 0; } }
#endif
        for (int rep = 0; rep < probe_reps(ph); ++rep) {
            CParams pp = (CParams)__builtin_amdgcn_kernarg_segment_ptr();
            asm volatile("" : "+s"(pp));
            PA q; q.pp = pp;
            run_phase(smem, q, ph, rep);
            if (ph == 0) {
                grid.sync();
                if (tidx() == 0) { st[0] = 0u; st[1] = 0u; }
                __syncthreads();
                xb = xcd_barrier_post((unsigned*)(q.ws() + WS_BAR), st);
            } else if (ph + 1 < NPHASE) {
                xcd_barrier(xb);
#if PROBE == 3
                xcd_barrier(xb);
#endif
            }
        }
    }
}

extern "C" void kernel_launch(void* const* d_in, const int* in_sizes, int n_in, void* d_out, int out_size, void* d_ws, size_t ws_size, hipStream_t stream) {
    static int grid_blocks = 0;
    if (grid_blocks == 0) {
        if (n_in != N_IN || ws_size < WS_END) { fprintf(stderr, "kernel_launch: unexpected n_in %d or ws_size %zu (need %zu)\n", n_in, ws_size, (size_t)WS_END); grid_blocks = -1; return; }
        int dev = 0, cus = 0, per_cu = 0;
        hipGetDevice(&dev);
        hipDeviceGetAttribute(&cus, hipDeviceAttributeMultiprocessorCount, dev);
        if (hipFuncSetAttribute((const void*)fwd_megakernel, hipFuncAttributeMaxDynamicSharedMemorySize, LDS_BYTES) != hipSuccess) { fprintf(stderr, "kernel_launch: hipFuncSetAttribute failed\n"); grid_blocks = -1; return; }
        hipOccupancyMaxActiveBlocksPerMultiprocessor(&per_cu, (const void*)fwd_megakernel, 512, LDS_BYTES);
        if (per_cu < 1) { fprintf(stderr, "kernel_launch: occupancy query reports %d blocks per CU\n", per_cu); per_cu = 1; }
        grid_blocks = cus;
    }
    if (grid_blocks < 0) return;
    Params p{};
    for (int i = 0; i < N_IN; ++i) p.in[i] = (const float*)d_in[i];
    p.out = (float*)d_out; p.ws = (unsigned char*)d_ws;
    void* args[] = {&p};
    hipError_t e = hipLaunchCooperativeKernel((const void*)fwd_megakernel, dim3(grid_blocks), dim3(512), args, LDS_BYTES, stream);
    if (e != hipSuccess) fprintf(stderr, "cooperative launch failed: %s (grid %d)\n", hipGetErrorString(e), grid_blocks);
}
```

```cpp
#include <hip/hip_runtime.h>
#include <hip/hip_cooperative_groups.h>
#include <cstdio>
namespace cg = cooperative_groups;

#ifndef PROBE
#define PROBE 0
#endif
#ifndef STAGGER
#define STAGGER 0
#endif
#define DI __device__ __forceinline__
#define LAS __attribute__((address_space(3)))
typedef unsigned short bf16_t;
typedef short bf16x8 __attribute__((ext_vector_type(8)));
typedef float f32x4 __attribute__((ext_vector_type(4)));
typedef unsigned u32x4 __attribute__((ext_vector_type(4)));
typedef unsigned u32x2 __attribute__((ext_vector_type(2)));

constexpr int NT = 24576, NCTX = 8192, NA2 = 26624;
constexpr float EPS = 1e-6f;
constexpr float LOG2E = 1.4426950408889634f;
constexpr int ZC_U = 416, ZC_VML = 928, ZC_GATES = 1952, ZC_QG = 1968, ZC_END = 2480;
enum { I_XP = 0, I_XS, I_CCKV, I_CKROPE, I_CGK, I_CGV, I_SC, I_SN, I_SM, I_C, I_CCTX, I_WADA, I_BADA, I_GN1, I_GN2, I_WIN, I_GMQ, I_WUQ, I_GMKV, I_WUKV,
       I_WMLC, I_BMLC, I_WMLQ, I_WMLK, I_BGATES, I_GMLOUT, I_GGQ, I_GGK, I_WOUT, I_WUP, I_WFC, I_BFC, I_WDN, I_GFIN, N_IN };
constexpr size_t O_X = 0, O_CKV = 25165824, O_KROPE = 27262976, O_GK = 27787264, O_GV = 29884416, O_C = 31981568, O_N = 40370176, O_M = 40435712;
constexpr size_t WS_CTRL = 0, WS_BAR = 4096, WS_ROPE = 20480, WS_MOD = 32768, WS_W = WS_MOD + 442368;
constexpr size_t W_IN = 0, W_B2 = W_IN + 5242880, W_B3 = W_B2 + 786432, W_OUT = W_B3 + 1048576, W_UP = W_OUT + 2097152, W_DN = W_UP + 11534336, W_SZ = W_UP + 25165824;
constexpr size_t WS_RA = WS_W + W_SZ, RSZ = 50331648;
constexpr size_t WS_RB = WS_RA + RSZ, WS_RC = WS_RB + RSZ, WS_RE = WS_RC + RSZ, WS_RF = WS_RE + 25165824;
constexpr size_t F_GATES = 0, F_CKG = F_GATES + 1572864, F_CVG = F_CKG + 524288, F_KROPE = F_CVG + 524288, F_QMLA = F_KROPE + 1703936, F_KVMLA = F_QMLA + 18874368, F_SZ = F_KVMLA + 27262976;
constexpr size_t WS_END = WS_RF + F_SZ;
static_assert(WS_END <= 268435456ull, "workspace over 256 MiB");
static_assert(WS_RB + (size_t)NT * 2816 * 2 + (size_t)384 * 6 * 2816 * 4 <= WS_END, "FFN buffers overflow");
constexpr int LDS_BYTES = 147456;

struct Params { const float* in[N_IN]; float* out; unsigned char* ws; };
struct PA { const __attribute__((address_space(4))) Params* pp;
    __device__ __forceinline__ const float* in(int i) const { return pp->in[i]; }
    __device__ __forceinline__ float* out() const { return pp->out; }
    __device__ __forceinline__ unsigned char* ws() const { return pp->ws; } };

DI int tidx() { int t = __builtin_amdgcn_workitem_id_x(); asm volatile("" : "+v"(t)); return t; }
DI int bidx() { int b = __builtin_amdgcn_workgroup_id_x(); asm volatile("" : "+s"(b)); return b; }
DI int gdim() { int g = (int)__ockl_get_num_groups(0); asm volatile("" : "+s"(g)); return g; }
typedef float f32x2 __attribute__((ext_vector_type(2)));
typedef __bf16 bf16x2v __attribute__((ext_vector_type(2)));
DI unsigned cvt_pk_bf16(float lo, float hi) { const f32x2 v = {lo, hi}; return __builtin_bit_cast(unsigned, __builtin_convertvector(v, bf16x2v)); }
DI float bf2f(bf16_t b) { return __uint_as_float(((unsigned)b) << 16); }
DI float bflo(unsigned u) { return __uint_as_float(u << 16); }
DI float bfhi(unsigned u) { return __uint_as_float(u & 0xffff0000u); }
DI bf16_t f2bf(float f) { return (bf16_t)(cvt_pk_bf16(f, 0.f) & 0xffffu); }
DI float max3f(float a, float b, float c) { return fmaxf(fmaxf(a, b), c); }
DI float exp2raw(float x) { return __builtin_amdgcn_exp2f(x); }
DI float wave_sum(float v) { for (int o = 32; o >= 1; o >>= 1) v += __shfl_xor(v, o); return v; }
DI float sigmoidf(float x) { return __builtin_amdgcn_rcpf(1.f + __builtin_amdgcn_exp2f(-LOG2E * x)); }
DI float siluf(float x) { return x * sigmoidf(x); }
DI float row_prev(float v) { return __builtin_bit_cast(float, __builtin_amdgcn_update_dpp(0, __builtin_bit_cast(int, v), 0x121, 0xf, 0xf, false)); }
DI float row_next(float v) { return __builtin_bit_cast(float, __builtin_amdgcn_update_dpp(0, __builtin_bit_cast(int, v), 0x12f, 0xf, 0xf, false)); }
DI float row_shr1(float edge, float v) { return __builtin_bit_cast(float, __builtin_amdgcn_update_dpp(__builtin_bit_cast(int, edge), __builtin_bit_cast(int, v), 0x111, 0xf, 0xf, false)); }
DI float row_shl1(float edge, float v) { return __builtin_bit_cast(float, __builtin_amdgcn_update_dpp(__builtin_bit_cast(int, edge), __builtin_bit_cast(int, v), 0x101, 0xf, 0xf, false)); }
DI int mod_index(int row) { return row < NCTX ? 0 : 1 + ((row - NCTX) >> 11); }
DI void seq_pos(int t, int& pos, int& T) { if (t < NCTX) { pos = t & 255; T = 256; } else { pos = (t - NCTX) & 2047; T = 2048; } }


#define XB_TMO      128
#define XB_XCNT(j)  (256  + 64 * (j))
#define XB_XSUB(j)  (1280 + 64 * (j))
#define XB_XGEN(j)  (2304 + 64 * (j))
#define XB_TOP      3328
#define XB_TOPGEN   3392
#define XCD_BAR_WORDS 3456
#define XB_SPIN_CAP (1u << 18)
DI unsigned xb_ld(unsigned* p)              { return __hip_atomic_load(p, __ATOMIC_RELAXED, __HIP_MEMORY_SCOPE_AGENT); }
DI unsigned xb_add(unsigned* p, unsigned v) { return __hip_atomic_fetch_add(p, v, __ATOMIC_RELAXED, __HIP_MEMORY_SCOPE_AGENT); }
DI unsigned xb_xcc_id() { return (unsigned)__builtin_amdgcn_s_getreg((3 << 11) | 20) & 0xFu; }
#define XB_SPIN(cond, bar) do { unsigned _sp = 0; while (cond) { __builtin_amdgcn_s_sleep(1); \
    if ((++_sp & 255u) == 0u) { if (xb_ld(&(bar)[XB_TMO])) break; if (_sp > XB_SPIN_CAP) { atomicAdd(&(bar)[XB_TMO], 1u); break; } } } } while (0)
struct XcdBarrier { unsigned* bar; unsigned x; volatile LAS unsigned* st; };
DI XcdBarrier xcd_barrier_post(unsigned* bar, volatile LAS unsigned* st) {
    XcdBarrier b; b.bar = bar; b.x = xb_xcc_id(); b.st = st;
    if (tidx() == 0) (void)xb_add(&bar[XB_XCNT(b.x)], 1u);
    return b;
}
DI void xcd_barrier_complete(unsigned* bar, unsigned x, unsigned& nloc, unsigned& nx) {
    const unsigned G = (unsigned)gdim();
    unsigned sum, cnt, mine, sp = 0u;
    for (;;) {
        sum = 0u; cnt = 0u; mine = 0u;
#pragma unroll
        for (unsigned j = 0; j < 16; ++j) { const unsigned c = xb_ld(&bar[XB_XCNT(j)]); sum += c; cnt += (c > 0u) ? 1u : 0u; mine = (j == x) ? c : mine; }
        if (sum == G) break;
        __builtin_amdgcn_s_sleep(1);
        if ((++sp & 255u) == 0u) { if (xb_ld(&bar[XB_TMO])) break; if (sp > XB_SPIN_CAP) { atomicAdd(&bar[XB_TMO], 1u); break; } }
    }
    nloc = mine > 0u ? mine : 1u; nx = cnt > 0u ? cnt : 1u;
}
DI void xcd_barrier(const XcdBarrier& b) {
    asm volatile("s_waitcnt vmcnt(0)" ::: "memory");
    __syncthreads();
    if (tidx() == 0) {
        unsigned* bar = b.bar;
        __builtin_amdgcn_s_waitcnt(0);
        unsigned nloc = b.st[0], nx = b.st[1];
        if (nloc == 0u) { xcd_barrier_complete(bar, b.x, nloc, nx); b.st[0] = nloc; b.st[1] = nx; }
        const unsigned old = xb_add(&bar[XB_XSUB(b.x)], 1u);
        const unsigned gen = old / nloc;
        if (old + 1u == (gen + 1u) * nloc) {
            __builtin_amdgcn_fence(__ATOMIC_RELEASE, "agent");
            asm volatile("s_waitcnt vmcnt(0)" ::: "memory");
            const unsigned og = xb_add(&bar[XB_TOP], 1u);
            const unsigned tg = og / nx;
            if (og + 1u == (tg + 1u) * nx) xb_add(&bar[XB_TOPGEN], 1u);
            else XB_SPIN(xb_ld(&bar[XB_TOPGEN]) == tg, bar);
            __builtin_amdgcn_fence(__ATOMIC_ACQUIRE, "agent");
            xb_add(&bar[XB_XGEN(b.x)], 1u);
            asm volatile("s_waitcnt vmcnt(0)" ::: "memory");
        } else {
            XB_SPIN(xb_ld(&bar[XB_XGEN(b.x)]) == gen, bar);
            __builtin_amdgcn_fence(__ATOMIC_ACQUIRE, "agent");
            asm volatile("s_waitcnt vmcnt(0)" ::: "memory");
        }
    }
    __syncthreads();
}

namespace pg8 {
constexpr int BM = 256, BK = 64, HALF = 128, HTB = HALF * BK * 2, STAGE_BYTES = 8 * HTB, NXCD = 8, WGM = 4;
DI int lds_byte(int r, int c) { const int st = (r >> 4) * 2 + (c >> 5), rr = r & 15, cc = c & 31, ob = rr * 64 + cc * 2; return st * 1024 + (ob ^ (((ob >> 9) & 1) << 5)); }
DI void stage_rc(int b, int& R, int& C) { const int st = b / 1024, sb = b % 1024, swz = sb ^ (((sb >> 9) & 1) << 5); R = (st >> 1) * 16 + swz / 64; C = (st & 1) * 32 + (swz % 64) / 2; }
struct Unit { int pm, pn; };
struct Gemm { const bf16_t* A; const bf16_t* Bt; int M, N, K; };
struct StaticOrder {
    int nM, nN, nwg, G, c;
    DI void init(int M, int N, int G_, int c_) { nM = M / BM; nN = N / BM; nwg = nM * nN; G = G_; c = c_; }
    DI bool next(int i, Unit& u) const {
        const long L = (long)i * G + c; if (L >= nwg) return false;
        int wgid = (int)L; { const int q = nwg / NXCD, r = nwg % NXCD, xcd = wgid % NXCD, off = wgid / NXCD; wgid = (xcd < r ? xcd * (q + 1) : r * (q + 1) + (xcd - r) * q) + off; }
        const int nig = WGM * nN, gid = wgid / nig, fm = gid * WGM, gsz = (nM - fm) < WGM ? (nM - fm) : WGM;
        u.pm = fm + ((wgid % nig) % gsz); u.pn = (wgid % nig) / gsz; return true;
    }
};
template <class Epi>
DI void gemm_phase(LAS unsigned char* lds, const Gemm g, const StaticOrder& S, const Epi& E) {
    const int tid = tidx(), wid = __builtin_amdgcn_readfirstlane(tid >> 6), lane = tid & 63, wr = wid >> 2, wc = wid & 3, fr = lane & 15, fq = lane >> 4;
    const int K = g.K, nt = K / BK;
    unsigned voffA[2];
#pragma unroll
    for (int i = 0; i < 2; ++i) { int R, C; stage_rc(tid * 16 + i * 8192, R, C); voffA[i] = (unsigned)(R * K + C) * 2u; }
    const size_t kstep = (size_t)(BK * 2);
    const size_t hstep = (size_t)HALF * K * 2;
    const size_t tstep = 2 * hstep;
    const unsigned ldsw = (unsigned)wid * 1024u;
    const int aoff = lds_byte(wr * 64 + fr, fq * 8), boff = lds_byte(wc * 32 + fr, fq * 8);
#define PG8_SA(b, h) (((b) * 2 + (h)) * HTB)
#define PG8_SB(b, h) ((4 + (b) * 2 + (h)) * HTB)
#define PG8_STAGE(bufoff, gbase, voff) do { _Pragma("unroll") for (int _i = 0; _i < 2; ++_i) \
        __builtin_amdgcn_global_load_lds((const unsigned*)((const char*)(gbase) + (voff)[_i]), (LAS unsigned*)(lds + (bufoff) + ldsw + _i * 8192), 16, 0, 0); } while (0)
#define PG8_LDA(dst, b, h) do { _Pragma("unroll") for (int m = 0; m < 4; ++m) _Pragma("unroll") for (int k = 0; k < 2; ++k) dst[m][k] = *(const LAS bf16x8*)(lds + PG8_SA(b, h) + aoff + m * 2048 + k * 1024); } while (0)
#define PG8_LDB(dst, b, h) do { _Pragma("unroll") for (int n = 0; n < 2; ++n) _Pragma("unroll") for (int k = 0; k < 2; ++k) dst[n][k] = *(const LAS bf16x8*)(lds + PG8_SB(b, h) + boff + n * 2048 + k * 1024); } while (0)
#define PG8_MMA(ai, bj, At, Bt) do { __builtin_amdgcn_s_setprio(1); _Pragma("unroll") for (int m = 0; m < 4; ++m) _Pragma("unroll") for (int n = 0; n < 2; ++n) _Pragma("unroll") for (int k = 0; k < 2; ++k) \
        acc[ai][bj][m][n] = __builtin_amdgcn_mfma_f32_16x16x32_bf16(Bt[n][k], At[m][k], acc[ai][bj][m][n], 0, 0, 0); __builtin_amdgcn_s_setprio(0); } while (0)
#define PG8_WAIT_V(n) asm volatile("s_waitcnt vmcnt(" #n ")" ::: "memory")
#define PG8_WAIT_L(n) asm volatile("s_waitcnt lgkmcnt(" #n ")" ::: "memory")
#define PG8_BAR __builtin_amdgcn_s_barrier()
#define PG8_SCHED __builtin_amdgcn_sched_barrier(0)
    Unit cur, nxt; int ui = 0;
    if (!S.next(0, cur)) return;
    f32x4 acc[2][2][4][2];
#pragma unroll
    for (int a = 0; a < 2; ++a)
#pragma unroll
        for (int b = 0; b < 2; ++b)
#pragma unroll
            for (int m = 0; m < 4; ++m)
#pragma unroll
                for (int n = 0; n < 2; ++n) acc[a][b][m][n] = (f32x4){0.f, 0.f, 0.f, 0.f};
    bf16x8 At[4][2], B0[2][2], B1[2][2];
    const char* cA = (const char*)g.A + (size_t)cur.pm * tstep; const char* cB = (const char*)g.Bt + (size_t)cur.pn * tstep;
    PG8_STAGE(PG8_SB(0, 0), cB, voffA); PG8_STAGE(PG8_SA(0, 0), cA, voffA); PG8_STAGE(PG8_SB(0, 1), cB + hstep, voffA); PG8_STAGE(PG8_SA(0, 1), cA + hstep, voffA);
    if (wr == 1) PG8_BAR;
    PG8_WAIT_V(4); PG8_BAR;
    PG8_STAGE(PG8_SB(1, 0), cB + kstep, voffA); PG8_STAGE(PG8_SA(1, 0), cA + kstep, voffA); PG8_STAGE(PG8_SB(1, 1), cB + hstep + kstep, voffA);
    PG8_WAIT_V(6); PG8_BAR;
    for (;;) {
        const bool has_next = S.next(ui + 1, nxt);
        const char* nA = has_next ? (const char*)g.A + (size_t)nxt.pm * tstep : cA; const char* nB = has_next ? (const char*)g.Bt + (size_t)nxt.pn * tstep : cB;
#pragma nounroll
        for (int t = 0; t < nt; t += 2) {
            const bool last = (t == nt - 2);
            const char* a1 = cA + (size_t)(t + 1) * kstep;
            const char* a2 = last ? nA : cA + (size_t)(t + 2) * kstep; const char* b2 = last ? nB : cB + (size_t)(t + 2) * kstep;
            const char* a3 = a2 + kstep; const char* b3 = b2 + kstep;
            PG8_LDB(B0, 0, 0); PG8_SCHED; PG8_LDA(At, 0, 0); PG8_STAGE(PG8_SA(1, 1), a1 + hstep, voffA);
            PG8_WAIT_L(8); PG8_BAR; PG8_WAIT_L(0); PG8_MMA(0, 0, At, B0); PG8_BAR; PG8_SCHED;
            PG8_LDB(B1, 0, 1); PG8_STAGE(PG8_SB(0, 0), b2, voffA);
            PG8_BAR; PG8_WAIT_L(0); PG8_MMA(0, 1, At, B1); PG8_BAR;
            PG8_LDA(At, 0, 1); PG8_STAGE(PG8_SA(0, 0), a2, voffA);
            PG8_BAR; PG8_WAIT_L(0); PG8_MMA(1, 0, At, B0); PG8_BAR; PG8_SCHED;
            PG8_STAGE(PG8_SB(0, 1), b2 + hstep, voffA);
            PG8_WAIT_V(6); PG8_BAR; PG8_MMA(1, 1, At, B1); PG8_BAR;
            PG8_LDB(B0, 1, 0); PG8_SCHED; PG8_LDA(At, 1, 0); PG8_STAGE(PG8_SA(0, 1), a2 + hstep, voffA);
            PG8_WAIT_L(8); PG8_BAR; PG8_WAIT_L(0); PG8_MMA(0, 0, At, B0); PG8_BAR; PG8_SCHED;
            PG8_LDB(B1, 1, 1); PG8_STAGE(PG8_SB(1, 0), b3, voffA);
            PG8_BAR; PG8_WAIT_L(0); PG8_MMA(0, 1, At, B1); PG8_BAR;
            PG8_LDA(At, 1, 1); PG8_STAGE(PG8_SA(1, 0), a3, voffA);
            PG8_BAR; PG8_WAIT_L(0); PG8_MMA(1, 0, At, B0); PG8_BAR; PG8_SCHED;
            PG8_STAGE(PG8_SB(1, 1), b3 + hstep, voffA);
            PG8_WAIT_V(6); PG8_BAR; PG8_MMA(1, 1, At, B1); PG8_BAR;
        }
        E(acc, cur, wr, wc, fr, fq);
#if PROBE == 12
        if (Epi::ID != 3) E(acc, cur, wr, wc, fr, fq);
#endif
        if (!has_next) break;
#pragma unroll
        for (int a = 0; a < 2; ++a)
#pragma unroll
            for (int b = 0; b < 2; ++b)
#pragma unroll
                for (int m = 0; m < 4; ++m)
#pragma unroll
                    for (int n = 0; n < 2; ++n) acc[a][b][m][n] = (f32x4){0.f, 0.f, 0.f, 0.f};
        cur = nxt; cA = nA; cB = nB; ++ui;
    }
    PG8_WAIT_V(0);
    if (wr == 0) PG8_BAR;
    PG8_BAR;
#undef PG8_SA
#undef PG8_SB
#undef PG8_STAGE
#undef PG8_LDA
#undef PG8_LDB
#undef PG8_MMA
#undef PG8_WAIT_V
#undef PG8_WAIT_L
#undef PG8_BAR
#undef PG8_SCHED
}
}
using pg8::Unit;

template <class F> DI void epi_foreach(const f32x4 (&acc)[2][2][4][2], const Unit& u, const F& f) {
    const int tl = tidx();
    const int fr = tl & 15, fq = (tl >> 4) & 3, wc = (tl >> 6) & 3, wr = tl >> 8;
    const int row0 = u.pm * 256 + wr * 64 + fr, col0 = u.pn * 256 + wc * 64 + 8 * fq;
#pragma unroll
    for (int ai = 0; ai < 2; ++ai)
#pragma unroll
        for (int m = 0; m < 4; ++m)
#pragma unroll
            for (int bj = 0; bj < 2; ++bj) f(row0 + ai * 128 + m * 16, col0 + bj * 32, acc[ai][bj][m][0], acc[ai][bj][m][1]);
}
DI void st_bf16x4(bf16_t* p, f32x4 v) { u32x2 w; w.x = cvt_pk_bf16(v[0], v[1]); w.y = cvt_pk_bf16(v[2], v[3]); *(u32x2*)p = w; }
DI void st_bf16x8(bf16_t* p, f32x4 v0, f32x4 v1) { u32x4 w; w.x = cvt_pk_bf16(v0[0], v0[1]); w.y = cvt_pk_bf16(v0[2], v0[3]); w.z = cvt_pk_bf16(v1[0], v1[1]); w.w = cvt_pk_bf16(v1[2], v1[3]); *(u32x4*)p = w; }

struct EpiIn { static constexpr int ID = 0;
    bf16_t* z1a; bf16_t* z2; bf16_t* z1b; float* gates; const float* bg;
    DI void operator()(const f32x4 (&acc)[2][2][4][2], const Unit& u, int, int, int, int) const {
        epi_foreach(acc, u, [&](int r, int c, f32x4 v0, f32x4 v1) {
            if (c < ZC_VML) st_bf16x8(z1a + (size_t)r * 928 + c, v0, v1);
            else if (c < ZC_GATES) st_bf16x8(z2 + (size_t)r * 1024 + (c - ZC_VML), v0, v1);
            else if (c < ZC_QG) { const f32x4 b0 = *(const f32x4*)(bg + (c - ZC_GATES)), b1 = *(const f32x4*)(bg + (c - ZC_GATES) + 4);
                                  *(f32x4*)(gates + (size_t)r * 16 + (c - ZC_GATES)) = v0 + b0; *(f32x4*)(gates + (size_t)r * 16 + (c - ZC_GATES) + 4) = v1 + b1; }
            else if (c < ZC_END) st_bf16x8(z1b + (size_t)r * 512 + (c - ZC_QG), v0, v1);
        });
    }
};
struct EpiA2 { static constexpr int ID = 1;
    bf16_t* qmla; bf16_t* kvmla; const f32x2* rope;
    DI void operator()(const f32x4 (&acc)[2][2][4][2], const Unit& u, int, int, int, int) const {
        epi_foreach(acc, u, [&](int r, int c, f32x4 v0, f32x4 v1) {
            if (c < 384) {
                if (r < NT) {
                    const int d = c % 96;
                    if (d >= 64 && r >= NCTX) {
                        const int pos = (r - NCTX) & 2047; const int half = (d - 64) >> 4, i0 = ((d - 64) & 15) >> 1;
                        const f32x2* t = rope + (half ? (pos & 63) : (pos >> 6)) * 8 + i0;
                        const f32x2 t0 = t[0], t1 = t[1], t2 = t[2], t3 = t[3];
                        v0 = (f32x4){v0[0] * t0.x - v0[1] * t0.y, v0[0] * t0.y + v0[1] * t0.x, v0[2] * t1.x - v0[3] * t1.y, v0[2] * t1.y + v0[3] * t1.x};
                        v1 = (f32x4){v1[0] * t2.x - v1[1] * t2.y, v1[0] * t2.y + v1[1] * t2.x, v1[2] * t3.x - v1[3] * t3.y, v1[2] * t3.y + v1[3] * t3.x};
                    }
                    st_bf16x8(qmla + (size_t)r * 384 + c, v0, v1);
                }
            } else if (c < 896) st_bf16x8(kvmla + (size_t)r * 512 + (c - 384), v0, v1);
        });
    }
};
struct EpiA3 { static constexpr int ID = 2;
    bf16_t* qk3;
    DI void operator()(const f32x4 (&acc)[2][2][4][2], const Unit& u, int, int, int, int) const {
        epi_foreach(acc, u, [&](int r, int c, f32x4 v0, f32x4 v1) {
            if (c >= 512) { v0 = v0 * 0.08838834764831845f; v1 = v1 * 0.08838834764831845f; }
            st_bf16x8(qk3 + (size_t)r * 1024 + c, v0, v1);
        });
    }
};
struct EpiRes { static constexpr int ID = 3;
    const float* src0; const float* src1; float* dst; const float* gate;
    DI void operator()(const f32x4 (&acc)[2][2][4][2], const Unit& u, int, int, int, int) const {
        const int tl = tidx(); const int fr = tl & 15, fq = (tl >> 4) & 3, wc = (tl >> 6) & 3, wr = tl >> 8;
        const int row0 = u.pm * 256 + wr * 64 + fr, col0 = u.pn * 256 + wc * 64 + 8 * fq;
        const float* gp = gate + (size_t)mod_index(u.pm * 256) * 6144 + col0;
        f32x4 g[2][2];
#pragma unroll
        for (int bj = 0; bj < 2; ++bj)
#pragma unroll
            for (int n = 0; n < 2; ++n) g[bj][n] = *(const f32x4*)(gp + bj * 32 + n * 4);
        const float* sbase = (u.pm * 256 < NCTX) ? src0 + (size_t)row0 * 1024 : src1 + (size_t)(row0 - NCTX) * 1024;
        float* dbase = dst + (size_t)row0 * 1024;
#pragma unroll
        for (int ai = 0; ai < 2; ++ai)
#pragma unroll
            for (int mp = 0; mp < 2; ++mp) {
                f32x4 x[2][2][2];
#pragma unroll
                for (int mm = 0; mm < 2; ++mm)
#pragma unroll
                    for (int bj = 0; bj < 2; ++bj)
#pragma unroll
                        for (int n = 0; n < 2; ++n) x[mm][bj][n] = *(const f32x4*)(sbase + (size_t)(ai * 128 + (2 * mp + mm) * 16) * 1024 + col0 + bj * 32 + n * 4);
#pragma unroll
                for (int mm = 0; mm < 2; ++mm)
#pragma unroll
                    for (int bj = 0; bj < 2; ++bj)
#pragma unroll
                        for (int n = 0; n < 2; ++n) *(f32x4*)(dbase + (size_t)(ai * 128 + (2 * mp + mm) * 16) * 1024 + col0 + bj * 32 + n * 4) = x[mm][bj][n] + g[bj][n] * acc[ai][bj][2 * mp + mm][n];
            }
    }
};
struct EpiUp { static constexpr int ID = 5;
    bf16_t* H; float* GB; float* AB; const float* wc; const float* bc;
    DI void operator()(const f32x4 (&acc)[2][2][4][2], const Unit& u, int, int, int, int) const {
        const int tl = tidx(); const int fr = tl & 15, fq = (tl >> 4) & 3, wcol = (tl >> 6) & 3, wr = tl >> 8;
        const int j = u.pn * 128 + wcol * 32 + 8 * fq;
        f32x4 w0[2], w1[2], w2[2], bb[2];
#pragma unroll
        for (int n = 0; n < 2; ++n) { w0[n] = *(const f32x4*)(wc + j + 4 * n); w1[n] = *(const f32x4*)(wc + 2816 + j + 4 * n); w2[n] = *(const f32x4*)(wc + 2 * 2816 + j + 4 * n); bb[n] = *(const f32x4*)(bc + j + 4 * n); }
#pragma unroll
        for (int ai = 0; ai < 2; ++ai)
#pragma unroll
            for (int m = 0; m < 4; ++m) {
                const int r = u.pm * 256 + ai * 128 + wr * 64 + m * 16 + fr;
                const int rr = (m * 16 + fr);
                f32x4 o[2];
#pragma unroll
                for (int n = 0; n < 2; ++n) {
                    const f32x4 a4 = acc[ai][0][m][n], g4 = acc[ai][1][m][n];
#pragma unroll
                    for (int i = 0; i < 4; ++i) {
                        float pm = 0.f, nm = 0.f;
                        if (m > 0) pm = row_prev(acc[ai][1][m > 0 ? m - 1 : 0][n][i]);
                        if (m < 3) nm = row_next(acc[ai][1][m < 3 ? m + 1 : 3][n][i]);
                        const float gp = row_shr1(pm, g4[i]), gn = row_shl1(nm, g4[i]);
                        o[n][i] = siluf(bb[n][i] + w0[n][i] * gp + w1[n][i] * g4[i] + w2[n][i] * gn) * a4[i];
                    }
                }
                if (rr != 0 && rr != 63) st_bf16x8(H + (size_t)r * 2816 + j, o[0], o[1]);
                if (rr <= 1 || rr >= 62) {
                    const int slot = rr <= 1 ? rr : rr - 60;
                    float* gb = GB + ((size_t)(r >> 6) * 4 + slot) * 2816 + j; *(f32x4*)gb = acc[ai][1][m][0]; *(f32x4*)(gb + 4) = acc[ai][1][m][1];
                    if (rr == 0 || rr == 63) { float* ab = AB + ((size_t)(r >> 6) * 2 + (rr == 63 ? 1 : 0)) * 2816 + j; *(f32x4*)ab = acc[ai][0][m][0]; *(f32x4*)(ab + 4) = acc[ai][0][m][1]; }
                }
            }
    }
};
template <class Epi> DI void run_gemm(unsigned char* smem, const bf16_t* A, const bf16_t* Bt, int M, int N, int K, const Epi& E) {
    pg8::Gemm g; g.A = A; g.Bt = Bt; g.M = M; g.N = N; g.K = K;
    pg8::StaticOrder S; S.init(M, N, (int)gdim(), (int)bidx());
    pg8::gemm_phase<Epi>((LAS unsigned char*)smem, g, S, E);
    __syncthreads();
}
DI int gemm_first_idle(int M, int N) { const int rem = ((M / 256) * (N / 256)) % gdim(); return rem == 0 ? gdim() : rem; }
DI int up_srccol(int n) { const int hb = n >> 8, r = n & 255; return r < 128 ? hb * 128 + r : 2816 + hb * 128 + (r - 128); }
DI int perm_row(int n) { const int rho = n & 31, nn = rho >> 4, i = rho & 15; return (n & ~31) + 8 * (i >> 2) + 4 * nn + (i & 3); }
DI int perm_row2(int n) { const int p = perm_row(n); const int s = p & 255, bj = s >> 7, wc = (s >> 5) & 3; return (p & ~255) + 64 * wc + 32 * bj + (s & 31); }
DI void convert_tiled(unsigned char* smem, const float* src, int ld, int K, int Nd, int nsrc, int kind, bf16_t* dst, int& item, const int nblk) {
    float* tile = (float*)smem;
    const int tk = K / 64, tn = Nd / 64, ntiles = tk * tn, tid = tidx();
    for (; item < ntiles; item += 2 * nblk) {
        float v[2][8];
#pragma unroll
        for (int tt = 0; tt < 2; ++tt) { const int it = item + tt * nblk; if (it < ntiles) {
            const int k0 = (it % tk) * 64, n0 = (it / tk) * 64;
            const int nn = tid & 63; const int n = kind >= 3 ? perm_row(n0 + nn + (kind == 4 ? 2816 : 0)) : perm_row2(n0 + nn); const int sc = kind >= 3 ? up_srccol(n) : (n < nsrc ? n : -1);
#pragma unroll
            for (int i = 0; i < 8; ++i) { const int kk = (tid >> 6) + 8 * i; v[tt][i] = sc >= 0 ? src[(size_t)(k0 + kk) * ld + sc] : 0.f; } } }
#pragma unroll
        for (int tt = 0; tt < 2; ++tt) { const int nn = tid & 63;
#pragma unroll
            for (int i = 0; i < 8; ++i) { const int kk = (tid >> 6) + 8 * i; tile[tt * 4160 + kk * 65 + nn] = v[tt][i]; } }
        __syncthreads();
#pragma unroll
        for (int tt = 0; tt < 2; ++tt) { const int it = item + tt * nblk; if (it < ntiles) {
            const int k0 = (it % tk) * 64, n0 = (it / tk) * 64;
#pragma unroll
            for (int i = 0; i < 8; ++i) { const int n2 = (tid >> 6) + 8 * i; const int k2 = tid & 63; dst[(size_t)(n0 + n2) * K + k0 + k2] = f2bf(tile[tt * 4160 + k2 * 65 + n2]); } } }
        __syncthreads();
    }
    item -= ntiles; if (item >= nblk) item -= nblk;
}
DI void convert_weights_b(unsigned char* smem, const PA& p, int l, int part, int bi, int nb) {
    unsigned char* W = p.ws() + WS_W;
    int item = bi;
    const float* wup = p.in(I_WUP) + (size_t)l * 1024 * 5632;
    if (part == 0) {
        convert_tiled(smem, wup, 5632, 1024, 2816, 5632, 3, (bf16_t*)(W + W_UP), item, nb);
        convert_tiled(smem, p.in(I_WDN) + (size_t)l * 2816 * 1024, 1024, 2816, 1024, 1024, 0, (bf16_t*)(W + W_DN), item, nb);
    } else {
        convert_tiled(smem, wup, 5632, 1024, 2816, 5632, 4, (bf16_t*)(W + W_UP) + (size_t)2816 * 1024, item, nb);
    }
}
DI void convert_weights(unsigned char* smem, const PA& p, int l, int bi, int nb) {
    unsigned char* W = p.ws() + WS_W;
    int item = bi;
    convert_tiled(smem, p.in(I_WIN) + (size_t)l * 1024 * 2480, 2480, 1024, 2560, 2480, 0, (bf16_t*)(W + W_IN), item, nb);
    convert_tiled(smem, p.in(I_WOUT) + (size_t)l * 1024 * 1024, 1024, 1024, 1024, 1024, 0, (bf16_t*)(W + W_OUT), item, nb);
    const float* wuq = p.in(I_WUQ) + (size_t)l * 256 * 384; const float* wukv = p.in(I_WUKV) + (size_t)l * 128 * 512;
    const float* wq = p.in(I_WMLQ) + (size_t)l * 4 * 128 * 128; const float* wk = p.in(I_WMLK) + (size_t)l * 4 * 128 * 128;
    bf16_t* b2 = (bf16_t*)(W + W_B2); bf16_t* b3 = (bf16_t*)(W + W_B3);
    const int gt = bi * 512 + tidx(), gs = nb * 512;
    for (int e = gt; e < 1024 * 384; e += gs) {
        const int n = perm_row2(e / 384), k = e % 384; float v = 0.f;
        if (n < 384) { if (k < 256) { const int hh = n / 96, r = n % 96; int sc = n;
                if (r >= 64) { const int q = r - 64, half = q >> 4, pp = q & 15; const int nat = (pp & 1) ? 8 + (pp >> 1) : (pp >> 1); sc = hh * 96 + 64 + half * 16 + nat; }
                v = wuq[(size_t)k * 384 + sc]; } }
        else if (n < 896) { if (k >= 256) v = wukv[(size_t)(k - 256) * 512 + (n - 384)]; }
        b2[e] = f2bf(v);
    }
    for (int e = gt; e < 1024 * 512; e += gs) {
        const int n = perm_row2(e / 512), k = e % 512; const int hh = (n & 511) >> 7, ee = n & 127; float v = 0.f;
        if ((k >> 7) == hh) v = (n < 512 ? wq : wk)[(size_t)hh * 16384 + (size_t)(k & 127) * 128 + ee];
        b3[e] = f2bf(v);
    }
}

DI void phase_mod(unsigned char* smem, const PA& p) {
    float* sv = (float*)smem;
    float* red = sv + 9 * 1024;
    const int tid = tidx(), wid = tid >> 6, lane = tid & 63;
    for (int e = tid; e < 9 * 1024; e += 512) { const int v = e >> 10, k = e & 1023; const float x = v == 0 ? p.in(I_CCTX)[k] : p.in(I_C)[(size_t)(v - 1) * 1024 + k]; sv[e] = siluf(x); }
    __syncthreads();
    float* mod = (float*)(p.ws() + WS_MOD);
    for (int item = bidx(); item < 192; item += gdim()) {
        const int l = item / 96, col0 = (item % 96) * 64;
        const float* w = p.in(I_WADA) + (size_t)l * 1024 * 6144 + col0 + lane;
        float acc[9];
#pragma unroll
        for (int v = 0; v < 9; ++v) acc[v] = 0.f;
        const int kb = wid * 128;
#pragma unroll 4
        for (int k4 = 0; k4 < 32; ++k4) {
            float wv[4];
#pragma unroll
            for (int j = 0; j < 4; ++j) wv[j] = w[(size_t)(kb + 4 * k4 + j) * 6144];
#pragma unroll
            for (int v = 0; v < 9; ++v) { const f32x4 s4 = *(const f32x4*)(sv + v * 1024 + kb + 4 * k4); acc[v] += s4[0] * wv[0] + s4[1] * wv[1] + s4[2] * wv[2] + s4[3] * wv[3]; } }
#pragma unroll
        for (int v = 0; v < 9; ++v) red[(wid * 9 + v) * 64 + lane] = acc[v];
        __syncthreads();
        for (int e = tid; e < 576; e += 512) { const int v = e >> 6, cc = e & 63; float s = p.in(I_BADA)[(size_t)l * 6144 + col0 + cc];
#pragma unroll
            for (int w8 = 0; w8 < 8; ++w8) s += red[(w8 * 9 + v) * 64 + cc];
            mod[((size_t)l * 9 + v) * 6144 + col0 + cc] = s; }
        __syncthreads();
    }
}

DI void phase_norm(const PA& p, int l, int which, bf16_t* Y) {
    const int lane = tidx() & 63, gw = bidx() * 8 + (tidx() >> 6), nw = gdim() * 8;
    const float* g = p.in(which == 1 ? I_GN1 : I_GN2) + (size_t)l * 1024;
    const float* mod = (const float*)(p.ws() + WS_MOD) + (size_t)l * 9 * 6144;
    const float* X = p.out(); const float* xp = p.in(I_XP); const float* xs = p.in(I_XS);
    const bool from_in = (l == 0 && which == 1);
    constexpr int R = 3;
    for (int row0 = gw; row0 < NT; row0 += nw * R) {
        f32x4 x[R][4]; float ss[R];
#pragma unroll
        for (int r = 0; r < R; ++r) { const int row = row0 + r * nw; ss[r] = 0.f;
            if (row < NT) { const float* src = from_in ? (row < NCTX ? xp + (size_t)row * 1024 : xs + (size_t)(row - NCTX) * 1024) : X + (size_t)row * 1024;
#pragma unroll
                for (int i = 0; i < 4; ++i) x[r][i] = *(const f32x4*)(src + lane * 4 + 256 * i); } }
#pragma unroll
        for (int r = 0; r < R; ++r) { const int row = row0 + r * nw; if (row >= NT) continue;
#pragma unroll
            for (int i = 0; i < 4; ++i) ss[r] += x[r][i][0] * x[r][i][0] + x[r][i][1] * x[r][i][1] + x[r][i][2] * x[r][i][2] + x[r][i][3] * x[r][i][3];
            ss[r] = wave_sum(ss[r]); const float rstd = rsqrtf(ss[r] * (1.f / 1024.f) + EPS);
            const float* mv = mod + (size_t)mod_index(row) * 6144 + (which == 1 ? 0 : 3072);
#pragma unroll
            for (int i = 0; i < 4; ++i) { const int c = lane * 4 + 256 * i; const f32x4 gg = *(const f32x4*)(g + c), sh = *(const f32x4*)(mv + c), sc = *(const f32x4*)(mv + 1024 + c);
                const f32x4 y = (x[r][i] * rstd) * gg * (sc + 1.f) + sh; st_bf16x4(Y + (size_t)row * 1024 + c, y); } }
    }
}
DI void phase_final(const PA& p) {
    const int lane = tidx() & 63, gw = bidx() * 8 + (tidx() >> 6), nw = gdim() * 8;
    const float* g = p.in(I_GFIN); float* X = p.out();
    constexpr int R = 3;
    for (int row0 = gw; row0 < NT; row0 += nw * R) {
        f32x4 x[R][4];
#pragma unroll
        for (int r = 0; r < R; ++r) { const int row = row0 + r * nw;
            if (row < NT) {
#pragma unroll
                for (int i = 0; i < 4; ++i) x[r][i] = *(const f32x4*)(X + (size_t)row * 1024 + lane * 4 + 256 * i); } }
#pragma unroll
        for (int r = 0; r < R; ++r) { const int row = row0 + r * nw; if (row >= NT) continue; float ss = 0.f;
#pragma unroll
            for (int i = 0; i < 4; ++i) ss += x[r][i][0] * x[r][i][0] + x[r][i][1] * x[r][i][1] + x[r][i][2] * x[r][i][2] + x[r][i][3] * x[r][i][3];
            ss = wave_sum(ss); const float rstd = rsqrtf(ss * (1.f / 1024.f) + EPS);
#pragma unroll
            for (int i = 0; i < 4; ++i) { const int c = lane * 4 + 256 * i; *(f32x4*)(X + (size_t)row * 1024 + c) = (x[r][i] * rstd) * *(const f32x4*)(g + c); } }
    }
}

DI float rope_inv(int i, float per) { return exp2f(-(float)i * per); }
DI void phase_prep(const PA& p, int l) {
    const int lane = tidx() & 63, gw = bidx() * 8 + (tidx() >> 6), nw = gdim() * 8;
    unsigned char* ws = p.ws();
    const bf16_t* Z1a = (const bf16_t*)(ws + WS_RB); bf16_t* Z1b = (bf16_t*)(ws + WS_RE);
    bf16_t* A2 = (bf16_t*)(ws + WS_RA); bf16_t* A3 = A2 + (size_t)NA2 * 384;
    bf16_t* KR = (bf16_t*)(ws + WS_RF + F_KROPE); bf16_t* CKG = (bf16_t*)(ws + WS_RF + F_CKG); bf16_t* CVG = (bf16_t*)(ws + WS_RF + F_CVG);
    const float* gq = p.in(I_GMQ) + (size_t)l * 256; const float* gkv = p.in(I_GMKV) + (size_t)l * 128;
    const float* wc = p.in(I_WMLC) + (size_t)l * 3 * 512; const float* bc = p.in(I_BMLC) + (size_t)l * 512;
    const float* ggq = p.in(I_GGQ) + (size_t)l * 64; const float* ggk = p.in(I_GGK) + (size_t)l * 64;
    const f32x2* ropem = (const f32x2*)(ws + WS_ROPE); const f32x2* ropeg = ropem + 512;
    for (int row = NT + gw; row < NA2; row += nw) {
        const int b = (row - NT) >> 8, j = (row - NT) & 255; const size_t cr = ((size_t)(b * 2 + l) * 256 + j);
        { unsigned zz = 0u; asm volatile("" : "+v"(zz)); u32x2 z; z.x = zz; z.y = zz; *(u32x2*)(A2 + (size_t)row * 384 + lane * 4) = z; }
        { const float* s_ = p.in(I_CCKV) + cr * 128 + lane * 2; *(unsigned*)(A2 + (size_t)row * 384 + 256 + lane * 2) = cvt_pk_bf16(s_[0], s_[1]); }
        if (lane < 16) { const int half = lane >> 3, i = lane & 7; const float* s_ = p.in(I_CKROPE) + cr * 32 + half * 16; *(unsigned*)(KR + (size_t)row * 32 + half * 16 + 2 * i) = cvt_pk_bf16(s_[i], s_[i + 8]); }
        { const float* s_ = p.in(I_CGK) + cr * 128 + lane * 2; *(unsigned*)(CKG + ((size_t)(b * 256 + j)) * 128 + lane * 2) = cvt_pk_bf16(s_[0], s_[1]); }
        { const float* s_ = p.in(I_CGV) + cr * 128 + lane * 2; *(unsigned*)(CVG + ((size_t)(b * 256 + j)) * 128 + lane * 2) = cvt_pk_bf16(s_[0], s_[1]); }
    }
    { const int j0 = lane * 8; float wv[3][8], bv[8];
#pragma unroll
      for (int j = 0; j < 8; ++j) { bv[j] = bc[j0 + j]; wv[0][j] = wc[j0 + j]; wv[1][j] = wc[512 + j0 + j]; wv[2][j] = wc[1024 + j0 + j]; }
      constexpr int R = 3;
      for (int row0 = gw; row0 < NT; row0 += nw * R) {
          u32x4 uv[R][3];
#pragma unroll
          for (int r = 0; r < R; ++r) { const int t = row0 + r * nw; if (t < NT) { int pos, T; seq_pos(t, pos, T);
#pragma unroll
              for (int d = 0; d < 3; ++d) { const int pp = pos + d - 1; uv[r][d] = (pp >= 0 && pp < T) ? *(const u32x4*)(Z1a + (size_t)(t + d - 1) * 928 + ZC_U + j0) : (u32x4){0u, 0u, 0u, 0u}; } } }
#pragma unroll
          for (int r = 0; r < R; ++r) { const int t = row0 + r * nw; if (t >= NT) continue;
              unsigned o[4];
#pragma unroll
              for (int k = 0; k < 4; ++k) { const unsigned* u0 = (const unsigned*)&uv[r][0]; const unsigned* u1 = (const unsigned*)&uv[r][1]; const unsigned* u2 = (const unsigned*)&uv[r][2];
                  const float c0 = bv[2 * k] + wv[0][2 * k] * bflo(u0[k]) + wv[1][2 * k] * bflo(u1[k]) + wv[2][2 * k] * bflo(u2[k]);
                  const float c1 = bv[2 * k + 1] + wv[0][2 * k + 1] * bfhi(u0[k]) + wv[1][2 * k + 1] * bfhi(u1[k]) + wv[2][2 * k + 1] * bfhi(u2[k]);
                  o[k] = cvt_pk_bf16(siluf(c0), siluf(c1)); }
              *(u32x4*)(A3 + (size_t)t * 512 + j0) = (u32x4){o[0], o[1], o[2], o[3]}; }
      } }
    const f32x4 gq4 = *(const f32x4*)(gq + lane * 4); const float gkv0 = gkv[lane * 2], gkv1 = gkv[lane * 2 + 1];
    const int li = lane & 15, d0 = li * 4;
    const f32x4 ggq4 = *(const f32x4*)(ggq + d0), ggk4 = *(const f32x4*)(ggk + d0);
    constexpr int R2 = 2;
    for (int row0 = gw; row0 < NT; row0 += nw * R2) {
        u32x2 wq[R2], wz[R2][2], wvg[R2]; unsigned wkv[R2], wkr[R2];
#pragma unroll
        for (int r = 0; r < R2; ++r) { const int t = row0 + r * nw; if (t < NT) {
            const bf16_t* z = Z1a + (size_t)t * 928; const bf16_t* zb = Z1b + (size_t)t * 512;
            wq[r] = *(const u32x2*)(z + lane * 4); wkv[r] = *(const unsigned*)(z + 256 + lane * 2);
            wkr[r] = lane < 16 ? ((unsigned)z[384 + (lane >> 3) * 16 + (lane & 7)] | ((unsigned)z[384 + (lane >> 3) * 16 + (lane & 7) + 8] << 16)) : 0u;
            wz[r][0] = *(const u32x2*)(zb + lane * 4); wz[r][1] = lane < 32 ? *(const u32x2*)(zb + 256 + lane * 4) : (u32x2){0u, 0u};
            wvg[r] = (t < NCTX && lane >= 32) ? *(const u32x2*)(zb + 384 + (lane - 32) * 4) : (u32x2){0u, 0u}; } }
#pragma unroll
        for (int r = 0; r < R2; ++r) { const int t = row0 + r * nw; if (t >= NT) continue;
            int pos, T; seq_pos(t, pos, T); const bool ctx = t < NCTX; const int b = ctx ? (t >> 8) : 0;
            const size_t orow = ((size_t)(b * 2 + l) * 256 + pos);
            { float v[4] = {bflo(wq[r].x), bfhi(wq[r].x), bflo(wq[r].y), bfhi(wq[r].y)};
              float ss = v[0] * v[0] + v[1] * v[1] + v[2] * v[2] + v[3] * v[3]; ss = wave_sum(ss); const float rs = rsqrtf(ss * (1.f / 256.f) + EPS);
              st_bf16x4(A2 + (size_t)t * 384 + lane * 4, (f32x4){v[0] * rs * gq4[0], v[1] * rs * gq4[1], v[2] * rs * gq4[2], v[3] * rs * gq4[3]}); }
            { float v0 = bflo(wkv[r]), v1 = bfhi(wkv[r]);
              float ss = wave_sum(v0 * v0 + v1 * v1); const float rs = rsqrtf(ss * (1.f / 128.f) + EPS);
              v0 = v0 * rs * gkv0; v1 = v1 * rs * gkv1;
              *(unsigned*)(A2 + (size_t)t * 384 + 256 + lane * 2) = cvt_pk_bf16(v0, v1);
              if (ctx) { float* o = p.out() + O_CKV + orow * 128 + lane * 2; *(f32x2*)o = (f32x2){v0, v1}; } }
            if (lane < 16) { const int half = lane >> 3, i = lane & 7; float x1 = bflo(wkr[r]), x2 = bfhi(wkr[r]);
              if (ctx) { float* o = p.out() + O_KROPE + orow * 32 + half * 16; o[i] = x1; o[i + 8] = x2; }
              else { const f32x2 tt = ropem[(half ? (pos & 63) : (pos >> 6)) * 8 + i]; const float c = tt.x, sn = tt.y; const float o1 = x1 * c - x2 * sn, o2 = x1 * sn + x2 * c; x1 = o1; x2 = o2; }
              *(unsigned*)(KR + (size_t)t * 32 + half * 16 + 2 * i) = cvt_pk_bf16(x1, x2); }
            bf16_t* zb = Z1b + (size_t)t * 512;
#pragma unroll
            for (int part = 0; part < 2; ++part) {
                const bool act = part == 0 || lane < 32;
                const int off = part * 256 + lane * 4;
                const u32x2 w = wz[r][part];
                float v[4] = {bflo(w.x), bfhi(w.x), bflo(w.y), bfhi(w.y)};
                float ss = v[0] * v[0] + v[1] * v[1] + v[2] * v[2] + v[3] * v[3];
                ss += __shfl_xor(ss, 1); ss += __shfl_xor(ss, 2); ss += __shfl_xor(ss, 4); ss += __shfl_xor(ss, 8);
                const float rs = rsqrtf(ss * (1.f / 64.f) + EPS); const f32x4 gg = part == 0 ? ggq4 : ggk4;
#pragma unroll
                for (int j = 0; j < 4; ++j) v[j] = v[j] * rs * gg[j];
                if (part == 1 && ctx && act) { float* o = p.out() + O_GK + orow * 128 + lane * 4; *(f32x4*)o = (f32x4){v[0], v[1], v[2], v[3]}; }
                if (!ctx) {
                    float pr[4];
#pragma unroll
                    for (int j = 0; j < 4; ++j) pr[j] = __shfl_xor(v[j], 4);
                    const bool isx2 = (li & 4) != 0; const int pq = (li & 8) ? (pos & 63) : (pos >> 6);
#pragma unroll
                    for (int j = 0; j < 4; ++j) { const int i = (d0 + j) & 15; const f32x2 tt = ropeg[pq * 16 + i]; const float c = tt.x, sn = tt.y;
                        v[j] = isx2 ? (pr[j] * sn + v[j] * c) : (v[j] * c - pr[j] * sn); } }
                if (act) st_bf16x4(zb + off, (f32x4){v[0], v[1], v[2], v[3]});
            }
            if (ctx && lane >= 32) { const int c4 = (lane - 32) * 4; *(f32x4*)(p.out() + O_GV + orow * 128 + c4) = (f32x4){bflo(wvg[r].x), bfhi(wvg[r].x), bflo(wvg[r].y), bfhi(wvg[r].y)}; }
        }
    }
}

struct AttnArgs {
    const bf16_t* q; int qs;
    const bf16_t* ka0; const bf16_t* ka1; int kas0, kas1; const bf16_t* kb0; const bf16_t* kb1; int kbs0, kbs1; const bf16_t* v0; const bf16_t* v1; int vs0, vs1;
    int nt1, nt;
    bf16_t* o; int os; float sc;
};
template <int DK> DI void attn_item(unsigned char* smem, const AttnArgs& a) {
    constexpr int KST = DK + 8, CPR = DK / 8, NKS = DK / 32, KBYTES = 64 * KST * 2, BUFB = KBYTES + 64 * 72 * 2;
    const int tid = tidx(), wid = tid >> 6, lane = tid & 63, c = lane & 15, g = lane >> 4;
    bf16x8 qf[2][NKS];
#pragma unroll
    for (int qg = 0; qg < 2; ++qg)
#pragma unroll
        for (int ks = 0; ks < NKS; ++ks) qf[qg][ks] = *(const bf16x8*)(a.q + (size_t)(wid * 32 + qg * 16 + c) * a.qs + ks * 32 + g * 8);
    f32x4 O[4][2]; float mrun[2], lsum[2];
#pragma unroll
    for (int qg = 0; qg < 2; ++qg) { mrun[qg] = -INFINITY; lsum[qg] = 0.f;
#pragma unroll
        for (int db = 0; db < 4; ++db) O[db][qg] = (f32x4){0.f, 0.f, 0.f, 0.f}; }
    bf16x8 kreg[2], vreg[4];
    const int key0 = tid / CPR, cc0 = tid % CPR, key1 = (tid + 512) / CPR, cc1 = (tid + 512) % CPR;
    const bool has1 = DK > 64 && (tid + 512) < 64 * CPR; const bool isv = tid >= 256 && tid < 384; const int vt = tid - 256, sg = vt & 15, e0 = vt >> 4;
    const int vpos = 32 * (sg >> 3) + 8 * (sg & 3) + 4 * ((sg >> 2) & 1);
    const bf16_t* kp0; const bf16_t* kp1; const bf16_t* vp; int kst0, kst1, vst;
    auto rebase = [&](int seg) {
        const bf16_t* ka = seg ? a.ka1 : a.ka0; const bf16_t* kb = seg ? a.kb1 : a.kb0; const int kas = seg ? a.kas1 : a.kas0, kbs = seg ? a.kbs1 : a.kbs0;
        kp0 = cc0 < 8 ? ka + (size_t)key0 * kas + cc0 * 8 : kb + (size_t)key0 * kbs + (cc0 - 8) * 8; kst0 = 64 * (cc0 < 8 ? kas : kbs);
        kp1 = cc1 < 8 ? ka + (size_t)key1 * kas + cc1 * 8 : kb + (size_t)key1 * kbs + (cc1 - 8) * 8; kst1 = 64 * (cc1 < 8 ? kas : kbs);
        vst = seg ? a.vs1 : a.vs0; vp = (seg ? a.v1 : a.v0) + (size_t)(4 * sg) * vst + e0 * 8;
    };
    auto load_tile = [&]() {
        kreg[0] = *(const bf16x8*)kp0; kp0 += kst0;
        if (has1) { kreg[1] = *(const bf16x8*)kp1; kp1 += kst1; }
        if (isv) {
#pragma unroll
            for (int r = 0; r < 4; ++r) vreg[r] = *(const bf16x8*)(vp + (size_t)r * vst);
            vp += (size_t)64 * vst; }
    };
    auto write_tile = [&](int buf) {
        LAS bf16_t* Ks = (LAS bf16_t*)(smem + buf * BUFB); LAS bf16_t* VT = (LAS bf16_t*)(smem + buf * BUFB + KBYTES);
        *(LAS bf16x8*)(Ks + key0 * KST + cc0 * 8) = kreg[0];
        if (has1) *(LAS bf16x8*)(Ks + key1 * KST + cc1 * 8) = kreg[1];
        if (isv) {
#pragma unroll
            for (int j = 0; j < 8; ++j) { u32x2 w; w.x = ((unsigned)(unsigned short)vreg[0][j]) | (((unsigned)(unsigned short)vreg[1][j]) << 16); w.y = ((unsigned)(unsigned short)vreg[2][j]) | (((unsigned)(unsigned short)vreg[3][j]) << 16);
                *(LAS u32x2*)(VT + (e0 * 8 + j) * 72 + vpos) = w; } }
    };
    rebase(0); load_tile(); write_tile(0);
    if (a.nt > 1) { if (a.nt1 == 1) rebase(1); load_tile(); }
    __syncthreads();
    for (int kt = 0; kt < a.nt; ++kt) {
        if (kt + 1 < a.nt) write_tile((kt + 1) & 1);
        if (kt + 2 < a.nt) { if (kt + 2 == a.nt1) rebase(1); load_tile(); }
        const LAS bf16_t* Ks = (const LAS bf16_t*)(smem + (kt & 1) * BUFB); const LAS bf16_t* VT = (const LAS bf16_t*)(smem + (kt & 1) * BUFB + KBYTES);
        bf16x8 kf[NKS][4];
#pragma unroll
        for (int ks = 0; ks < NKS; ++ks)
#pragma unroll
            for (int sb = 0; sb < 4; ++sb) kf[ks][sb] = *(const LAS bf16x8*)(Ks + (16 * sb + c) * KST + ks * 32 + g * 8);
        f32x4 S[2][4];
#pragma unroll
        for (int qg = 0; qg < 2; ++qg)
#pragma unroll
            for (int sb = 0; sb < 4; ++sb) { f32x4 acc = (f32x4){0.f, 0.f, 0.f, 0.f};
#pragma unroll
                for (int ks = 0; ks < NKS; ++ks) acc = __builtin_amdgcn_mfma_f32_16x16x32_bf16(kf[ks][sb], qf[qg][ks], acc, 0, 0, 0);
                S[qg][sb] = acc; }
        bf16x8 vf[2][4];
#pragma unroll
        for (int u = 0; u < 2; ++u)
#pragma unroll
            for (int db = 0; db < 4; ++db) vf[u][db] = *(const LAS bf16x8*)(VT + (16 * db + c) * 72 + 32 * u + 8 * g);
#pragma unroll
        for (int qg = 0; qg < 2; ++qg) {
            float mx = max3f(max3f(S[qg][0][0], S[qg][0][1], S[qg][0][2]), max3f(S[qg][0][3], S[qg][1][0], S[qg][1][1]), max3f(S[qg][1][2], S[qg][1][3], S[qg][2][0]));
            mx = max3f(mx, max3f(S[qg][2][1], S[qg][2][2], S[qg][2][3]), max3f(S[qg][3][0], S[qg][3][1], S[qg][3][2]));
            mx = fmaxf(mx, S[qg][3][3]);
            if (__builtin_amdgcn_ballot_w64((mx - mrun[qg]) * a.sc > 8.f) != 0ull) {
                mx = fmaxf(mx, __shfl_xor(mx, 16)); mx = fmaxf(mx, __shfl_xor(mx, 32));
                const float mn = fmaxf(mrun[qg], mx); const float alpha = exp2raw((mrun[qg] - mn) * a.sc); mrun[qg] = mn;
                lsum[qg] *= alpha;
#pragma unroll
                for (int db = 0; db < 4; ++db) O[db][qg] = O[db][qg] * alpha;
            }
            const float mb = mrun[qg] * a.sc; float ps0 = 0.f, ps1 = 0.f;
            bf16x8 P[2];
#pragma unroll
            for (int sb = 0; sb < 4; ++sb) {
                const float p0 = exp2raw(__builtin_fmaf(S[qg][sb][0], a.sc, -mb)), p1 = exp2raw(__builtin_fmaf(S[qg][sb][1], a.sc, -mb));
                const float p2 = exp2raw(__builtin_fmaf(S[qg][sb][2], a.sc, -mb)), p3 = exp2raw(__builtin_fmaf(S[qg][sb][3], a.sc, -mb));
                S[qg][sb] = (f32x4){p0, p1, p2, p3}; ps0 += p0 + p2; ps1 += p1 + p3; }
            lsum[qg] += ps0 + ps1;
#pragma unroll
            for (int u = 0; u < 2; ++u) { u32x4 w; w.x = cvt_pk_bf16(S[qg][2 * u][0], S[qg][2 * u][1]); w.y = cvt_pk_bf16(S[qg][2 * u][2], S[qg][2 * u][3]);
                w.z = cvt_pk_bf16(S[qg][2 * u + 1][0], S[qg][2 * u + 1][1]); w.w = cvt_pk_bf16(S[qg][2 * u + 1][2], S[qg][2 * u + 1][3]); P[u] = __builtin_bit_cast(bf16x8, w); }
#pragma unroll
            for (int u = 0; u < 2; ++u)
#pragma unroll
                for (int db = 0; db < 4; ++db) O[db][qg] = __builtin_amdgcn_mfma_f32_16x16x32_bf16(vf[u][db], P[u], O[db][qg], 0, 0, 0);
        }
        __syncthreads();
    }
#pragma unroll
    for (int qg = 0; qg < 2; ++qg) {
        float l = lsum[qg]; l += __shfl_xor(l, 16); l += __shfl_xor(l, 32); const float inv = 1.f / l;
#pragma unroll
        for (int db = 0; db < 4; ++db) st_bf16x4(a.o + (size_t)(wid * 32 + qg * 16 + c) * a.os + 16 * db + 4 * g, O[db][qg] * inv);
    }
}

template <int SPLIT> DI void mlstm_item(unsigned char* smem, const PA& p, int l, int seq_is_lat, int b, int h, int dir, int eh) {
    constexpr int ST = 136, NEB = SPLIT ? 4 : 8, NDB = SPLIT ? 4 : 8, EROWS = 16 * NEB;
    LAS bf16_t* Ks = (LAS bf16_t*)smem; LAS bf16_t* KwT = Ks + 128 * ST; LAS bf16_t* VT = KwT + 128 * ST; LAS bf16_t* CT = VT + EROWS * ST;
    LAS float* fv = (LAS float*)(smem + (256 + 2 * EROWS) * ST * 2);
    LAS float* s_bc = fv; LAS float* s_a = fv + 128; LAS float* s_M = fv + 256; LAS float* s_n = fv + 384;
    const int tid = tidx(), wid = tid >> 6, lane = tid & 63, c = lane & 15, g = lane >> 4;
    const int we = SPLIT ? (wid & 3) : wid, wd = SPLIT ? (wid >> 2) : 0;
    unsigned char* ws = p.ws();
    const bf16_t* QK3 = (const bf16_t*)(ws + WS_RB); const bf16_t* Z2 = (const bf16_t*)(ws + WS_RC); const float* gates = (const float*)(ws + WS_RF + F_GATES);
    bf16_t* CAT = (bf16_t*)(ws + WS_RA); bf16_t* HB = (bf16_t*)(ws + WS_W + W_UP);
    const int T = seq_is_lat ? 2048 : 256, nc = T / 128; const int tok0 = seq_is_lat ? NCTX + b * 2048 : b * 256;
    const int e_off = eh * 64;
    f32x4 Cacc[NDB]; float m_prev;
    const size_t sidx = (((size_t)b * 2 + l) * 2 + dir) * 4 + h;
    if (seq_is_lat) {
        const float* c0 = p.in(I_SC) + sidx * 16384;
#pragma unroll
        for (int db = 0; db < NDB; ++db) Cacc[db] = *(const f32x4*)(c0 + (size_t)((NDB * wd + db) * 16 + c) * 128 + e_off + 16 * we + 4 * g);
        if (tid < 128) s_n[tid] = p.in(I_SN)[sidx * 128 + tid];
        m_prev = p.in(I_SM)[sidx];
    } else {
#pragma unroll
        for (int db = 0; db < NDB; ++db) Cacc[db] = (f32x4){0.f, 0.f, 0.f, 0.f};
        if (tid < 128) s_n[tid] = 0.f;
        m_prev = 0.f;
    }
#pragma unroll
    for (int db = 0; db < NDB; ++db)
#pragma unroll
        for (int i = 0; i < 4; ++i) CT[(16 * we + 4 * g + i) * ST + (NDB * wd + db) * 16 + c] = f2bf(Cacc[db][i]);
    bf16x8 kpre[4], vpre[4]; float gpre[4];
    const int sgq = tid & 31, e0q = tid >> 5;
    auto rowof = [&](int ck, int pidx) { const int P = ck * 128 + pidx; return tok0 + (dir == 0 ? P : T - 1 - P); };
    auto load_pre = [&](int ck) {
#pragma unroll
        for (int i = 0; i < 4; ++i) { const int q = tid + 512 * i, s_ = q >> 4, cc = q & 15; kpre[i] = *(const bf16x8*)(QK3 + (size_t)rowof(ck, s_) * 1024 + 512 + h * 128 + cc * 8); }
        if (tid < 64 * NEB) {
#pragma unroll
            for (int r = 0; r < 4; ++r) vpre[r] = *(const bf16x8*)(Z2 + (size_t)rowof(ck, 4 * sgq + r) * 1024 + h * 128 + e_off + e0q * 8); }
        if (wid == 0) {
#pragma unroll
            for (int e = 0; e < 2; ++e) { const float* gr = gates + (size_t)rowof(ck, 2 * lane + e) * 16 + dir * 8 + h; gpre[2 * e] = gr[0]; gpre[2 * e + 1] = gr[4]; } }
    };
    load_pre(0);
    for (int ck = 0; ck < nc; ++ck) {
        if (wid == 0) {
            float li2[2], lf2[2];
#pragma unroll
            for (int e = 0; e < 2; ++e) { li2[e] = gpre[2 * e]; const float f = gpre[2 * e + 1]; lf2[e] = fminf(f, 0.f) - log1pf(__expf(-fabsf(f))); }
            float s1 = lf2[0] + lf2[1], inc = s1;
#pragma unroll
            for (int o = 1; o < 64; o <<= 1) { const float t2 = __shfl_up(inc, o); if (lane >= o) inc += t2; }
            const float ex = inc - s1; const float bc0 = ex + lf2[0], bc1 = ex + s1;
            const float a0 = li2[0] - bc0, a1 = li2[1] - bc1;
            float pm = fmaxf(a0, a1);
#pragma unroll
            for (int o = 1; o < 64; o <<= 1) { const float t2 = __shfl_up(pm, o); if (lane >= o) pm = fmaxf(pm, t2); }
            float pex = __shfl_up(pm, 1); if (lane == 0) pex = -INFINITY;
            s_bc[2 * lane] = bc0; s_bc[2 * lane + 1] = bc1; s_a[2 * lane] = a0; s_a[2 * lane + 1] = a1;
            s_M[2 * lane] = fmaxf(m_prev, fmaxf(pex, a0)); s_M[2 * lane + 1] = fmaxf(m_prev, pm);
        }
#pragma unroll
        for (int i = 0; i < 4; ++i) { const int q = tid + 512 * i, s_ = q >> 4, cc = q & 15; *(LAS bf16x8*)(Ks + s_ * ST + cc * 8) = kpre[i]; }
        const int trow = rowof(ck, 16 * wid + c);
        bf16x8 qf[4];
#pragma unroll
        for (int ks = 0; ks < 4; ++ks) qf[ks] = *(const bf16x8*)(QK3 + (size_t)trow * 1024 + h * 128 + ks * 32 + g * 8);
        __syncthreads();
        const float Mlast = s_M[127]; const float blast = s_bc[127];
        { float wk[4];
          { const f32x4 a4 = *(const LAS f32x4*)(s_a + 4 * sgq);
#pragma unroll
            for (int r = 0; r < 4; ++r) wk[r] = __expf(a4[r] - Mlast); }
          bf16x8 kr[4];
#pragma unroll
          for (int r = 0; r < 4; ++r) kr[r] = *(const LAS bf16x8*)(Ks + (4 * sgq + r) * ST + e0q * 8);
#pragma unroll
          for (int j = 0; j < 8; ++j) {
              u32x2 k2; k2.x = cvt_pk_bf16(bf2f((bf16_t)kr[0][j]) * wk[0], bf2f((bf16_t)kr[1][j]) * wk[1]); k2.y = cvt_pk_bf16(bf2f((bf16_t)kr[2][j]) * wk[2], bf2f((bf16_t)kr[3][j]) * wk[3]);
              *(LAS u32x2*)(KwT + (e0q * 8 + j) * ST + 4 * sgq) = k2; }
          if (tid < 64 * NEB) {
#pragma unroll
              for (int j = 0; j < 8; ++j) {
                  u32x2 w; w.x = ((unsigned)(unsigned short)vpre[0][j]) | (((unsigned)(unsigned short)vpre[1][j]) << 16); w.y = ((unsigned)(unsigned short)vpre[2][j]) | (((unsigned)(unsigned short)vpre[3][j]) << 16);
                  *(LAS u32x2*)(VT + (e0q * 8 + j) * ST + 4 * sgq) = w; } } }
        __syncthreads();
        if (ck + 1 < nc) load_pre(ck + 1);
        const int t = 16 * wid + c; const float Mt = s_M[t]; const float inter = __expf(m_prev - Mt);
        bf16x8 Pk[4]; float rowsum = 0.f;
#pragma unroll
        for (int u = 0; u < 4; ++u) {
            f32x4 S0 = (f32x4){0.f, 0.f, 0.f, 0.f}, S1 = S0;
#pragma unroll
            for (int ks = 0; ks < 4; ++ks) {
                const int k0 = 32 * u + 8 * (c >> 2) + (c & 3);
                const bf16x8 a0 = *(const LAS bf16x8*)(Ks + k0 * ST + ks * 32 + g * 8); const bf16x8 a1 = *(const LAS bf16x8*)(Ks + (k0 + 4) * ST + ks * 32 + g * 8);
                S0 = __builtin_amdgcn_mfma_f32_16x16x32_bf16(a0, qf[ks], S0, 0, 0, 0); S1 = __builtin_amdgcn_mfma_f32_16x16x32_bf16(a1, qf[ks], S1, 0, 0, 0);
            }
            float w8[8];
            const f32x4 a_lo = *(const LAS f32x4*)(s_a + 32 * u + 8 * g), a_hi = *(const LAS f32x4*)(s_a + 32 * u + 8 * g + 4);
#pragma unroll
            for (int i = 0; i < 4; ++i) { const int s0 = 32 * u + 8 * g + i, s1 = s0 + 4;
                w8[i] = s0 <= t ? S0[i] * __expf(a_lo[i] - Mt) : 0.f; w8[4 + i] = s1 <= t ? S1[i] * __expf(a_hi[i] - Mt) : 0.f; }
#pragma unroll
            for (int i = 0; i < 8; ++i) rowsum += w8[i];
            u32x4 w; w.x = cvt_pk_bf16(w8[0], w8[1]); w.y = cvt_pk_bf16(w8[2], w8[3]); w.z = cvt_pk_bf16(w8[4], w8[5]); w.w = cvt_pk_bf16(w8[6], w8[7]); Pk[u] = __builtin_bit_cast(bf16x8, w);
        }
        rowsum += __shfl_xor(rowsum, 16); rowsum += __shfl_xor(rowsum, 32);
        float qn = 0.f;
#pragma unroll
        for (int ks = 0; ks < 4; ++ks)
#pragma unroll
            for (int j = 0; j < 8; j += 4) { const f32x4 n4 = *(const LAS f32x4*)(s_n + ks * 32 + g * 8 + j);
                qn += bf2f((bf16_t)qf[ks][j]) * n4[0] + bf2f((bf16_t)qf[ks][j + 1]) * n4[1] + bf2f((bf16_t)qf[ks][j + 2]) * n4[2] + bf2f((bf16_t)qf[ks][j + 3]) * n4[3]; }
        qn += __shfl_xor(qn, 16); qn += __shfl_xor(qn, 32);
        const float den = rowsum + inter * qn; const float dnm = fmaxf(fabsf(den), __expf(-(s_bc[t] + Mt))); const float rden = 1.f / dnm;
        bf16_t* orow = dir == 0 ? CAT + (size_t)trow * 1024 + 256 + h * 128 + e_off : HB + (size_t)trow * 512 + h * 128 + e_off;
#pragma unroll
        for (int eb = 0; eb < NEB; ++eb) { f32x4 n4 = (f32x4){0.f, 0.f, 0.f, 0.f};
#pragma unroll
            for (int ks = 0; ks < 4; ++ks) { const bf16x8 af = *(const LAS bf16x8*)(CT + (16 * eb + c) * ST + ks * 32 + g * 8); n4 = __builtin_amdgcn_mfma_f32_16x16x32_bf16(af, qf[ks], n4, 0, 0, 0); }
            n4 = n4 * inter;
#pragma unroll
            for (int u = 0; u < 4; ++u) { const bf16x8 af = *(const LAS bf16x8*)(VT + (16 * eb + c) * ST + 32 * u + 8 * g); n4 = __builtin_amdgcn_mfma_f32_16x16x32_bf16(af, Pk[u], n4, 0, 0, 0); }
            st_bf16x4(orow + 16 * eb + 4 * g, n4 * rden); }
        const float decay = __expf(m_prev - Mlast);
        { bf16x8 af[4];
#pragma unroll
          for (int u = 0; u < 4; ++u) af[u] = *(const LAS bf16x8*)(VT + (16 * we + c) * ST + 32 * u + 8 * g);
#pragma unroll
          for (int db = 0; db < NDB; ++db) { f32x4 cc = Cacc[db] * decay;
#pragma unroll
              for (int u = 0; u < 4; ++u) { const bf16x8 bfr = *(const LAS bf16x8*)(KwT + (16 * (NDB * wd + db) + c) * ST + 32 * u + 8 * g); cc = __builtin_amdgcn_mfma_f32_16x16x32_bf16(af[u], bfr, cc, 0, 0, 0); }
              Cacc[db] = cc; } }
        float nnew = 0.f;
        if (tid < 128) { float sacc = 0.f;
#pragma unroll 4
            for (int s8 = 0; s8 < 16; ++s8) { const bf16x8 kk = *(const LAS bf16x8*)(KwT + tid * ST + s8 * 8);
#pragma unroll
                for (int j = 0; j < 8; ++j) sacc += bf2f((bf16_t)kk[j]); }
            nnew = decay * s_n[tid] + sacc; }
        m_prev = blast + Mlast;
        __syncthreads();
        if (tid < 128) s_n[tid] = nnew;
#pragma unroll
        for (int db = 0; db < NDB; ++db)
#pragma unroll
            for (int i = 0; i < 4; ++i) CT[(16 * we + 4 * g + i) * ST + (NDB * wd + db) * 16 + c] = f2bf(Cacc[db][i]);
    }
    __syncthreads();
    if (!seq_is_lat) {
        float* co = p.out() + O_C + sidx * 16384;
#pragma unroll
        for (int db = 0; db < NDB; ++db) *(f32x4*)(co + (size_t)((NDB * wd + db) * 16 + c) * 128 + e_off + 16 * we + 4 * g) = Cacc[db];
        if (eh == 0) { if (tid < 128) p.out()[O_N + sidx * 128 + tid] = s_n[tid];
                       if (tid == 0) p.out()[O_M + sidx] = m_prev; }
    }
    __syncthreads();
}

DI void phase_hn(const PA& p, int l) {
    const int lane = tidx() & 63, gw = bidx() * 8 + (tidx() >> 6), nw = gdim() * 8;
    unsigned char* ws = p.ws();
    bf16_t* CAT = (bf16_t*)(ws + WS_RA); const bf16_t* HB = (const bf16_t*)(ws + WS_W + W_UP); const bf16_t* Z2 = (const bf16_t*)(ws + WS_RC);
    const float* gout = p.in(I_GMLOUT) + (size_t)l * 512 + lane * 8;
    f32x4 g0 = *(const f32x4*)gout, g1 = *(const f32x4*)(gout + 4);
    constexpr int R = 4;
    for (int row0 = gw; row0 < NT; row0 += nw * R) {
        u32x4 a[R], b[R], o[R];
#pragma unroll
        for (int r = 0; r < R; ++r) { const int row = row0 + r * nw; if (row < NT) {
            a[r] = *(const u32x4*)(CAT + (size_t)row * 1024 + 256 + lane * 8); b[r] = *(const u32x4*)(HB + (size_t)row * 512 + lane * 8); o[r] = *(const u32x4*)(Z2 + (size_t)row * 1024 + 512 + lane * 8); } }
#pragma unroll
        for (int r = 0; r < R; ++r) { const int row = row0 + r * nw; if (row >= NT) continue;
            float v[8] = {bflo(a[r].x) + bflo(b[r].x), bfhi(a[r].x) + bfhi(b[r].x), bflo(a[r].y) + bflo(b[r].y), bfhi(a[r].y) + bfhi(b[r].y), bflo(a[r].z) + bflo(b[r].z), bfhi(a[r].z) + bfhi(b[r].z), bflo(a[r].w) + bflo(b[r].w), bfhi(a[r].w) + bfhi(b[r].w)};
            float ss = 0.f;
#pragma unroll
            for (int j = 0; j < 8; ++j) ss += v[j] * v[j];
            ss += __shfl_xor(ss, 1); ss += __shfl_xor(ss, 2); ss += __shfl_xor(ss, 4); ss += __shfl_xor(ss, 8);
            const float rs = rsqrtf(ss * (1.f / 128.f) + EPS);
            const float og[8] = {bflo(o[r].x), bfhi(o[r].x), bflo(o[r].y), bfhi(o[r].y), bflo(o[r].z), bfhi(o[r].z), bflo(o[r].w), bfhi(o[r].w)};
            const float gg[8] = {g0[0], g0[1], g0[2], g0[3], g1[0], g1[1], g1[2], g1[3]};
#pragma unroll
            for (int j = 0; j < 8; ++j) v[j] = v[j] * rs * gg[j] * sigmoidf(og[j]);
            u32x4 w; w.x = cvt_pk_bf16(v[0], v[1]); w.y = cvt_pk_bf16(v[2], v[3]); w.z = cvt_pk_bf16(v[4], v[5]); w.w = cvt_pk_bf16(v[6], v[7]);
            *(u32x4*)(CAT + (size_t)row * 1024 + 256 + lane * 8) = w; }
    }
}

DI void phase_mixers(unsigned char* smem, const PA& p, int l, int rep) {
    unsigned char* ws = p.ws();
    unsigned* ctr = (unsigned*)(ws + WS_CTRL) + 64 * (1 + l + 2 * rep);
    LAS int* s_item = (LAS int*)(smem + LDS_BYTES - 64);
    const bf16_t* QMLA = (const bf16_t*)(ws + WS_RF + F_QMLA); const bf16_t* KV = (const bf16_t*)(ws + WS_RF + F_KVMLA); const bf16_t* KR = (const bf16_t*)(ws + WS_RF + F_KROPE);
    const bf16_t* Z1b = (const bf16_t*)(ws + WS_RE); const bf16_t* CKG = (const bf16_t*)(ws + WS_RF + F_CKG); const bf16_t* CVG = (const bf16_t*)(ws + WS_RF + F_CVG);
    bf16_t* CAT = (bf16_t*)(ws + WS_RA);
    for (;;) {
        __syncthreads();
        if (tidx() == 0) *s_item = (int)atomicAdd(ctr, 1u);
        __syncthreads();
        const int it = *s_item;
        if (it >= 1088) break;
        if (it < 64) { mlstm_item<0>(smem, p, l, 1, it >> 3, (it >> 1) & 3, it & 1, 0); continue; }
        if (it >= 576 && it < 832) { const int j = it - 576; mlstm_item<0>(smem, p, l, 0, j >> 3, (j >> 1) & 3, j & 1, 0); continue; }
        int lat, kind, b, h, qb;
        if (it < 576) { const int j = it - 64; lat = 1; kind = j >> 8; const int r = j & 255; b = r >> 5; h = (r >> 3) & 3; qb = r & 7; }
        else { const int j = it - 832; lat = 0; kind = j >> 7; const int r = j & 127; b = r >> 2; h = r & 3; qb = 0; }
        const int tok0 = lat ? NCTX + b * 2048 : b * 256; const int q0 = tok0 + qb * 256;
        AttnArgs a;
        a.nt1 = lat ? 32 : 4; a.nt = lat ? 36 : 4;
        if (kind == 0) {
            a.q = QMLA + (size_t)q0 * 384 + h * 96; a.qs = 384;
            a.ka0 = KV + (size_t)tok0 * 512 + h * 128; a.kas0 = 512; a.kb0 = KR + (size_t)tok0 * 32; a.kbs0 = 32; a.v0 = KV + (size_t)tok0 * 512 + h * 128 + 64; a.vs0 = 512;
            const size_t cr = (size_t)NT + b * 256;
            a.ka1 = KV + cr * 512 + h * 128; a.kas1 = 512; a.kb1 = KR + cr * 32; a.kbs1 = 32; a.v1 = KV + cr * 512 + h * 128 + 64; a.vs1 = 512;
            a.o = CAT + (size_t)q0 * 1024 + h * 64; a.os = 1024; a.sc = 0.10206207261596577f * LOG2E;
            attn_item<96>(smem, a);
#if PROBE == 6
            attn_item<96>(smem, a);
#endif
        } else {
            const int kvh = h >> 1;
            a.q = Z1b + (size_t)q0 * 512 + h * 64; a.qs = 512;
            a.ka0 = Z1b + (size_t)tok0 * 512 + 256 + kvh * 64; a.kas0 = 512; a.kb0 = a.ka0; a.kbs0 = 512; a.v0 = Z1b + (size_t)tok0 * 512 + 384 + kvh * 64; a.vs0 = 512;
            a.ka1 = CKG + (size_t)b * 256 * 128 + kvh * 64; a.kas1 = 128; a.kb1 = a.ka1; a.kbs1 = 128; a.v1 = CVG + (size_t)b * 256 * 128 + kvh * 64; a.vs1 = 128;
            a.o = CAT + (size_t)q0 * 1024 + 768 + h * 64; a.os = 1024; a.sc = 0.125f * LOG2E;
            attn_item<64>(smem, a);
#if PROBE == 6
            attn_item<64>(smem, a);
#endif
        }
    }
}

DI void phase_ffix(const PA& p, int l, const float* GB, const float* AB, bf16_t* H) {
    const float* wc = p.in(I_WFC) + (size_t)l * 3 * 2816; const float* bc = p.in(I_BFC) + (size_t)l * 2816;
    const int total = 384 * 2 * 704;
    for (int e = bidx() * 512 + tidx(); e < total; e += gdim() * 512) {
        const int j = (e % 704) * 4, gr = e / 704, G = gr >> 1, hi = gr & 1;
        const int r = G * 64 + (hi ? 63 : 0); int pos, T; seq_pos(r, pos, T);
        const f32x4 zero = (f32x4){0.f, 0.f, 0.f, 0.f};
        f32x4 gp, gc, gn;
        if (!hi) { gp = pos > 0 ? *(const f32x4*)(GB + ((size_t)(G - 1) * 4 + 3) * 2816 + j) : zero; gc = *(const f32x4*)(GB + ((size_t)G * 4 + 0) * 2816 + j); gn = *(const f32x4*)(GB + ((size_t)G * 4 + 1) * 2816 + j); }
        else     { gp = *(const f32x4*)(GB + ((size_t)G * 4 + 2) * 2816 + j); gc = *(const f32x4*)(GB + ((size_t)G * 4 + 3) * 2816 + j); gn = pos < T - 1 ? *(const f32x4*)(GB + ((size_t)(G + 1) * 4 + 0) * 2816 + j) : zero; }
        const f32x4 a4 = *(const f32x4*)(AB + ((size_t)G * 2 + hi) * 2816 + j);
        const f32x4 w0 = *(const f32x4*)(wc + j), w1 = *(const f32x4*)(wc + 2816 + j), w2 = *(const f32x4*)(wc + 2 * 2816 + j), bb = *(const f32x4*)(bc + j);
        f32x4 o;
#pragma unroll
        for (int i = 0; i < 4; ++i) o[i] = siluf(bb[i] + w0[i] * gp[i] + w1[i] * gc[i] + w2[i] * gn[i]) * a4[i];
        st_bf16x4(H + (size_t)r * 2816 + j, o);
    }
}

constexpr int NPHASE = 24, PPL = 11;
DI int probe_reps(int ph) {
    if (ph == 0 || ph == NPHASE - 1) return 1;
    const int q = (ph - 1) % PPL;
    if (PROBE == 1) return q == 4 ? 2 : 1;
    if (PROBE == 2) return (q == 1 || q == 3 || q == 8) ? 2 : 1;
    if (PROBE == 4) return (q == 0 || q == 7 || q == 9) ? 2 : 1;
    if (PROBE == 8) return q == 1 ? 2 : 1;
    if (PROBE == 9) return q == 8 ? 2 : 1;
    if (PROBE == 10) return q == 3 ? 2 : 1;
    if (PROBE == 11) return q == 2 ? 1 : (q == 5 ? 2 : 1);
    return 1;
}
DI void run_phase(unsigned char* smem, const PA& p, int ph, int rep) {
    unsigned char* ws = p.ws();
    if (ph == 0) {
        if (bidx() == 0) for (int i = tidx(); i < 5120; i += 512) ((unsigned*)(ws + WS_CTRL))[i] = 0u;
        if (bidx() == gdim() - 1) {
            f32x2* tm = (f32x2*)(ws + WS_ROPE); f32x2* tg = tm + 512;
            for (int e = tidx(); e < 1536; e += 512) { const bool m = e < 512; const int ee = m ? e : e - 512; const int pos = m ? ee >> 3 : ee >> 4, i = m ? ee & 7 : ee & 15;
                float sn, cs; sincosf((float)pos * exp2f(-(float)i * (13.287712379549449f / (m ? 8.f : 16.f))), &sn, &cs); (m ? tm : tg)[ee] = (f32x2){cs, sn}; }
        }
        phase_mod(smem, p);
        convert_weights(smem, p, 0, bidx(), gdim());
        return;
    }
    if (ph == NPHASE - 1) { phase_final(p); return; }
    int l = (ph - 1) / PPL, q = (ph - 1) % PPL;
    asm volatile("" : "+s"(l), "+s"(q));
    unsigned char* W = ws + WS_W;
    const float* mod = (const float*)(ws + WS_MOD);
    bf16_t* RA = (bf16_t*)(ws + WS_RA); bf16_t* RB = (bf16_t*)(ws + WS_RB); bf16_t* RC = (bf16_t*)(ws + WS_RC); bf16_t* RE = (bf16_t*)(ws + WS_RE);
    bf16_t* H = RB; float* GB = (float*)(ws + WS_RB + (size_t)NT * 2816 * 2); float* AB = GB + (size_t)384 * 4 * 2816;
    switch (q) {
    case 0: phase_norm(p, l, 1, RA); break;
    case 1: { EpiIn e; e.z1a = RB; e.z2 = RC; e.z1b = RE; e.gates = (float*)(ws + WS_RF + F_GATES); e.bg = p.in(I_BGATES) + (size_t)l * 16;
              run_gemm(smem, RA, (const bf16_t*)(W + W_IN), NT, 2560, 1024, e); } break;
    case 2:
#ifndef NO_PREP
        phase_prep(p, l);
#endif
        break;
    case 3: { EpiA2 e; e.qmla = (bf16_t*)(ws + WS_RF + F_QMLA); e.kvmla = (bf16_t*)(ws + WS_RF + F_KVMLA); e.rope = (const f32x2*)(ws + WS_ROPE);
              run_gemm(smem, RA, (const bf16_t*)(W + W_B2), NA2, 1024, 384, e); }
            { EpiA3 e; e.qk3 = RB;
              run_gemm(smem, RA + (size_t)NA2 * 384, (const bf16_t*)(W + W_B3), NT, 1024, 512, e); } break;
    case 4:
#ifndef NO_MIX
        phase_mixers(smem, p, l, rep);
#endif
        break;
    case 5: phase_hn(p, l); break;
    case 6: { EpiRes e; e.src0 = l == 0 ? p.in(I_XP) : p.out(); e.src1 = l == 0 ? p.in(I_XS) : p.out() + (size_t)NCTX * 1024; e.dst = p.out(); e.gate = mod + (size_t)l * 9 * 6144 + 2048;
              run_gemm(smem, RA, (const bf16_t*)(W + W_OUT), NT, 1024, 1024, e);
              { const int fi = gemm_first_idle(NT, 1024); if (bidx() >= fi) convert_weights_b(smem, p, l, 0, bidx() - fi, gdim() - fi); else if (fi == gdim()) convert_weights_b(smem, p, l, 0, bidx(), gdim()); } } break;
    case 7: convert_weights_b(smem, p, l, 1, bidx(), gdim()); phase_norm(p, l, 2, RA); break;
    case 8: { EpiUp e; e.H = H; e.GB = GB; e.AB = AB; e.wc = p.in(I_WFC) + (size_t)l * 3 * 2816; e.bc = p.in(I_BFC) + (size_t)l * 2816;
              run_gemm(smem, RA, (const bf16_t*)(W + W_UP), NT, 5632, 1024, e);
              if (l == 0) { const int fi = gemm_first_idle(NT, 5632); if (bidx() >= fi) convert_weights(smem, p, 1, bidx() - fi, gdim() - fi); else if (fi == gdim()) convert_weights(smem, p, 1, bidx(), gdim()); } } break;
    case 9: phase_ffix(p, l, GB, AB, H); break;
    default: { EpiRes e; e.src0 = p.out(); e.src1 = p.out() + (size_t)NCTX * 1024; e.dst = p.out(); e.gate = mod + (size_t)l * 9 * 6144 + 5120;
               run_gemm(smem, H, (const bf16_t*)(W + W_DN), NT, 1024, 2816, e); } break;
    }
}
__global__ void __launch_bounds__(512, 2) fwd_megakernel(Params p) {
    extern __shared__ __attribute__((aligned(16))) unsigned char smem[];
    cg::grid_group grid = cg::this_grid();
    typedef const __attribute__((address_space(4))) Params* CParams;
    volatile LAS unsigned* st = (volatile LAS unsigned*)(smem + LDS_BYTES - 32);
    XcdBarrier xb; xb.bar = nullptr; xb.x = 0; xb.st = st;
    int redo = 0;
    for (int ph = 0; ph < NPHASE; ++ph) {
#if PROBE == 11
        if (ph > 0 && ph < NPHASE - 1) { const int q = (ph - 1) % PPL; if (q == 3) { if (!redo) { redo = 1; ph -= 2; } else redo = 0; } }
#endif
        for (int rep = 0; rep < probe_reps(ph); ++rep) {
            CParams pp = (CParams)__builtin_amdgcn_kernarg_segment_ptr();
            asm volatile("" : "+s"(pp));
            PA q; q.pp = pp;
            run_phase(smem, q, ph, rep);
            if (ph == 0) {
                grid.sync();
                if (tidx() == 0) { st[0] = 0u; st[1] = 0u; }
                __syncthreads();
                xb = xcd_barrier_post((unsigned*)(q.ws() + WS_BAR), st);
            } else if (ph + 1 < NPHASE) {
                xcd_barrier(xb);
#if PROBE == 3
                xcd_barrier(xb);
#endif
            }
        }
    }
}

extern "C" void kernel_launch(void* const* d_in, const int* in_sizes, int n_in, void* d_out, int out_size, void* d_ws, size_t ws_size, hipStream_t stream) {
    static int grid_blocks = 0;
    if (grid_blocks == 0) {
        if (n_in != N_IN || ws_size < WS_END) { fprintf(stderr, "kernel_launch: unexpected n_in %d or ws_size %zu (need %zu)\n", n_in, ws_size, (size_t)WS_END); grid_blocks = -1; return; }
        int dev = 0, cus = 0, per_cu = 0;
        hipGetDevice(&dev);
        hipDeviceGetAttribute(&cus, hipDeviceAttributeMultiprocessorCount, dev);
        if (hipFuncSetAttribute((const void*)fwd_megakernel, hipFuncAttributeMaxDynamicSharedMemorySize, LDS_BYTES) != hipSuccess) { fprintf(stderr, "kernel_launch: hipFuncSetAttribute failed\n"); grid_blocks = -1; return; }
        hipOccupancyMaxActiveBlocksPerMultiprocessor(&per_cu, (const void*)fwd_megakernel, 512, LDS_BYTES);
        if (per_cu < 1) { fprintf(stderr, "kernel_launch: occupancy query reports %d blocks per CU\n", per_cu); per_cu = 1; }
        grid_blocks = cus;
    }
    if (grid_blocks < 0) return;
    Params p{};
    for (int i = 0; i < N_IN; ++i) p.in[i] = (const float*)d_in[i];
    p.out = (float*)d_out; p.ws = (unsigned char*)d_ws;
    void* args[] = {&p};
    hipError_t e = hipLaunchCooperativeKernel((const void*)fwd_megakernel, dim3(grid_blocks), dim3(512), args, LDS_BYTES, stream);
    if (e != hipSuccess) fprintf(stderr, "cooperative launch failed: %s (grid %d)\n", hipGetErrorString(e), grid_blocks);
}
```
